# Optimizing an MI355X kernel written in HIP

```python
import jax
import jax.numpy as jnp
from jax import lax
import numpy as np


D_MODEL = 2048
BATCH = 4
SEQ = 4096
DEPTH = 2

POOL_WINDOWS = (2, 4, 8, 16)
N_POOL_GROUPS = len(POOL_WINDOWS)
POOL_GROUP_DIM = D_MODEL // N_POOL_GROUPS
HEAD_SIZE = 64
N_HEADS = D_MODEL // HEAD_SIZE
N_DIRS = 2
N_SHIFT_MIX = 6
DECAY_LORA = 96
ICLR_LORA = 96
GATE_LORA = 256
LNX_EPS = 64e-5
D_FF_DENSE = 5632
N_EXPERTS = 8
TOP_K = 2
D_FF_EXPERT = 7168
RMS_EPS = 1e-6

kernel_name = 'hybrid_pool_rwkv7_moe_encoder'


def rmsnorm(x, g):
    xf = x.astype(jnp.float32)
    y = xf * lax.rsqrt(jnp.mean(xf * xf, axis=-1, keepdims=True) + RMS_EPS)
    return (y * g.astype(jnp.float32)).astype(x.dtype)


def window_mean_minus_self(h, window):
    seq = h.shape[1]
    hf = h.astype(jnp.float32)
    csum = jnp.pad(lax.cumsum(hf, axis=1), ((0, 0), (1, 0), (0, 0)))
    pos = jnp.arange(seq)
    lo = jnp.clip(pos - window // 2, 0, seq)
    hi = jnp.clip(pos + window - window // 2, 0, seq)
    total = jnp.take(csum, hi, axis=1) - jnp.take(csum, lo, axis=1)
    count = (hi - lo).astype(jnp.float32)[None, :, None]
    return (total / count - hf).astype(h.dtype)


def pool_mixer(h, pool_w, pool_scale):
    bsz, seq, dim = h.shape
    groups = h.reshape(bsz, seq, N_POOL_GROUPS, POOL_GROUP_DIM)
    pooled = jnp.stack([window_mean_minus_self(groups[:, :, g], POOL_WINDOWS[g])
                        for g in range(N_POOL_GROUPS)], axis=2)
    mixed = jnp.einsum('bsgc,gce->bsge', pooled, pool_w).reshape(bsz, seq, dim)
    return mixed * pool_scale


def wkv_scan(r, decay, k, v, kk, a, inclusive, reverse):
    bsz = r.shape[1]
    state0 = jnp.zeros((bsz, N_HEADS, HEAD_SIZE, HEAD_SIZE), jnp.float32)

    def step(state, inp):
        r_t, w_t, k_t, v_t, kk_t, a_t = inp
        sa = jnp.einsum('bhvk,bhk->bhv', state, -kk_t)
        new = (state * w_t[:, :, None, :]
               + sa[..., None] * (kk_t * a_t)[:, :, None, :]
               + v_t[..., None] * k_t[:, :, None, :])
        read = new if inclusive else state
        y = jnp.einsum('bhvk,bhk->bhv', read, r_t)
        return new, y

    _, ys = lax.scan(step, state0, (r, decay, k, v, kk, a), reverse=reverse)
    return ys


def heads(t):
    return t.reshape(t.shape[:-1] + (N_HEADS, HEAD_SIZE))


def time_major(t):
    return jnp.swapaxes(t.astype(jnp.float32), 0, 1)


def rwkv7_bidir_mixer(h, mix, w_r, w_k, w_v, w_o, decay_w0, decay_w1, decay_w2,
                      iclr_a0, iclr_a1, iclr_a2, gate_g1, gate_g2, k_k, k_a, r_k,
                      lnx_w, lnx_b):
    bsz, seq, dim = h.shape
    f32 = jnp.float32
    prev = jnp.pad(h, ((0, 0), (1, 0), (0, 0)))[:, :-1]
    nxt = jnp.pad(h, ((0, 0), (0, 1), (0, 0)))[:, 1:]
    xx = 0.5 * (prev + nxt) - h
    xr, xw, xk, xv, xa, xg = [h + xx * mix[i] for i in range(N_SHIFT_MIX)]

    r = xr @ w_r
    k = xk @ w_k
    v = xv @ w_v
    w_lora = jnp.einsum('ebsr,erd->ebsd', jnp.tanh(jnp.einsum('bsd,edr->ebsr', xw, decay_w1)), decay_w2)
    w_log = -jax.nn.softplus(-(decay_w0[:, None, None, :].astype(f32) + w_lora.astype(f32))) - 0.5
    decay = jnp.exp(-jnp.exp(w_log))
    a_lora = jnp.einsum('ebsr,erd->ebsd', jnp.einsum('bsd,edr->ebsr', xa, iclr_a1), iclr_a2)
    a = jax.nn.sigmoid(iclr_a0[:, None, None, :].astype(f32) + a_lora.astype(f32))
    g = jax.nn.sigmoid(xg @ gate_g1) @ gate_g2

    kk = heads((k * k_k).astype(f32))
    kk = kk / jnp.maximum(jnp.linalg.norm(kk, axis=-1, keepdims=True), 1e-12)
    k_dir = k[None].astype(f32) * (1.0 + (a - 1.0) * k_a.astype(f32))

    r_h = heads(r.astype(f32))
    v_h = heads(v.astype(f32))
    r_tm, v_tm, kk_tm = time_major(r_h), time_major(v_h), time_major(kk)
    y_fwd = wkv_scan(r_tm, time_major(heads(decay[0])), time_major(heads(k_dir[0])), v_tm, kk_tm,
                     time_major(heads(a[0])), inclusive=True, reverse=False)
    y_bwd = wkv_scan(r_tm, time_major(heads(decay[1])), time_major(heads(k_dir[1])), v_tm, kk_tm,
                     time_major(heads(a[1])), inclusive=False, reverse=True)
    y = jnp.swapaxes(y_fwd + y_bwd, 0, 1)

    mu = jnp.mean(y, axis=-1, keepdims=True)
    var = jnp.mean(jnp.square(y - mu), axis=-1, keepdims=True)
    yn = ((y - mu) * lax.rsqrt(var + LNX_EPS)).reshape(bsz, seq, dim)
    yn = yn * lnx_w.astype(f32) + lnx_b.astype(f32)
    bonus = (jnp.sum(r_h * heads(k_dir[0]) * r_k.astype(f32), axis=-1, keepdims=True) * v_h).reshape(bsz, seq, dim)
    out = ((yn + bonus) * g.astype(f32)).astype(h.dtype)
    return out @ w_o


def swiglu(t, w_gate, w_up, w_down):
    return (jax.nn.silu(t @ w_gate) * (t @ w_up)) @ w_down


def moe_swiglu(h, router, w_gate, w_up, w_down):
    bsz, seq, dim = h.shape
    t = h.reshape(-1, dim)
    logits = (t @ router).astype(jnp.float32)
    top_v, top_i = lax.top_k(logits, TOP_K)
    gates = jax.nn.softmax(top_v, axis=-1)
    combine = jnp.sum(jax.nn.one_hot(top_i, N_EXPERTS, dtype=jnp.float32) * gates[..., None], axis=1)
    combine = combine.astype(t.dtype)
    out = jnp.zeros_like(t)
    for e in range(N_EXPERTS):
        out = out + combine[:, e:e + 1] * swiglu(t, w_gate[e], w_up[e], w_down[e])
    return out.reshape(bsz, seq, dim)


def setup_inputs(seed: int = 0) -> dict:
    key = jax.random.key(seed)
    ks = iter(list(jax.random.split(key, 40)))
    D = D_MODEL

    def nrm(shape, scale):
        return scale * jax.random.normal(next(ks), shape, jnp.float32)

    def unif(shape, lo, hi):
        return jax.random.uniform(next(ks), shape, jnp.float32, lo, hi)

    return {
        'x': nrm((BATCH, SEQ, D), 1.0),
        'l0_norm_mix': 1.0 + nrm((D,), 0.02),
        'l0_pool_w': nrm((N_POOL_GROUPS, POOL_GROUP_DIM, POOL_GROUP_DIM), POOL_GROUP_DIM ** -0.5),
        'l0_pool_scale': 1.0 + nrm((D,), 0.1),
        'l0_norm_ffn': 1.0 + nrm((D,), 0.02),
        'l0_ffn_w_gate': nrm((D, D_FF_DENSE), D ** -0.5),
        'l0_ffn_w_up': nrm((D, D_FF_DENSE), D ** -0.5),
        'l0_ffn_w_down': nrm((D_FF_DENSE, D), D_FF_DENSE ** -0.5),
        'l1_norm_mix': 1.0 + nrm((D,), 0.02),
        'l1_mix': unif((N_SHIFT_MIX, D), 0.0, 1.0),
        'l1_w_r': nrm((D, D), D ** -0.5),
        'l1_w_k': nrm((D, D), D ** -0.5),
        'l1_w_v': nrm((D, D), D ** -0.5),
        'l1_w_o': nrm((D, D), D ** -0.5),
        'l1_decay_w0': unif((N_DIRS, D), -6.0, -1.0),
        'l1_decay_w1': nrm((N_DIRS, D, DECAY_LORA), D ** -0.5),
        'l1_decay_w2': nrm((N_DIRS, DECAY_LORA, D), 0.5 * DECAY_LORA ** -0.5),
        'l1_iclr_a0': nrm((N_DIRS, D), 0.1),
        'l1_iclr_a1': nrm((N_DIRS, D, ICLR_LORA), D ** -0.5),
        'l1_iclr_a2': nrm((N_DIRS, ICLR_LORA, D), 0.5 * ICLR_LORA ** -0.5),
        'l1_gate_g1': nrm((D, GATE_LORA), D ** -0.5),
        'l1_gate_g2': nrm((GATE_LORA, D), GATE_LORA ** -0.5),
        'l1_k_k': 0.85 + nrm((D,), 0.05),
        'l1_k_a': 1.0 + nrm((D,), 0.05),
        'l1_r_k': nrm((N_HEADS, HEAD_SIZE), 0.1),
        'l1_lnx_w': 1.0 + nrm((D,), 0.1),
        'l1_lnx_b': nrm((D,), 0.01),
        'l1_norm_ffn': 1.0 + nrm((D,), 0.02),
        'l1_router': nrm((D, N_EXPERTS), D ** -0.5),
        'l1_moe_w_gate': nrm((N_EXPERTS, D, D_FF_EXPERT), D ** -0.5),
        'l1_moe_w_up': nrm((N_EXPERTS, D, D_FF_EXPERT), D ** -0.5),
        'l1_moe_w_down': nrm((N_EXPERTS, D_FF_EXPERT, D), D_FF_EXPERT ** -0.5),
        'final_norm': 1.0 + nrm((D,), 0.02),
    }


def reference(x, l0_norm_mix, l0_pool_w, l0_pool_scale, l0_norm_ffn, l0_ffn_w_gate, l0_ffn_w_up,
              l0_ffn_w_down, l1_norm_mix, l1_mix, l1_w_r, l1_w_k, l1_w_v, l1_w_o, l1_decay_w0,
              l1_decay_w1, l1_decay_w2, l1_iclr_a0, l1_iclr_a1, l1_iclr_a2, l1_gate_g1, l1_gate_g2,
              l1_k_k, l1_k_a, l1_r_k, l1_lnx_w, l1_lnx_b, l1_norm_ffn, l1_router, l1_moe_w_gate,
              l1_moe_w_up, l1_moe_w_down, final_norm):
    layers = (
        dict(norm_mix=l0_norm_mix, pool_w=l0_pool_w, pool_scale=l0_pool_scale,
             norm_ffn=l0_norm_ffn, w_gate=l0_ffn_w_gate, w_up=l0_ffn_w_up, w_down=l0_ffn_w_down),
        dict(norm_mix=l1_norm_mix, mix=l1_mix, w_r=l1_w_r, w_k=l1_w_k, w_v=l1_w_v, w_o=l1_w_o,
             decay_w0=l1_decay_w0, decay_w1=l1_decay_w1, decay_w2=l1_decay_w2,
             iclr_a0=l1_iclr_a0, iclr_a1=l1_iclr_a1, iclr_a2=l1_iclr_a2,
             gate_g1=l1_gate_g1, gate_g2=l1_gate_g2, k_k=l1_k_k, k_a=l1_k_a, r_k=l1_r_k,
             lnx_w=l1_lnx_w, lnx_b=l1_lnx_b, norm_ffn=l1_norm_ffn, router=l1_router,
             w_gate=l1_moe_w_gate, w_up=l1_moe_w_up, w_down=l1_moe_w_down),
    )
    h = x
    for i in range(DEPTH):
        p = layers[i]
        hn = rmsnorm(h, p['norm_mix'])
        if i % 2 == 0:
            h = h + pool_mixer(hn, p['pool_w'], p['pool_scale'])
        else:
            h = h + rwkv7_bidir_mixer(hn, p['mix'], p['w_r'], p['w_k'], p['w_v'], p['w_o'],
                                      p['decay_w0'], p['decay_w1'], p['decay_w2'],
                                      p['iclr_a0'], p['iclr_a1'], p['iclr_a2'],
                                      p['gate_g1'], p['gate_g2'], p['k_k'], p['k_a'], p['r_k'],
                                      p['lnx_w'], p['lnx_b'])
        hn = rmsnorm(h, p['norm_ffn'])
        if i % 2 == 0:
            h = h + swiglu(hn, p['w_gate'], p['w_up'], p['w_down'])
        else:
            h = h + moe_swiglu(hn, p['router'], p['w_gate'], p['w_up'], p['w_down'])
    return rmsnorm(h, final_norm)
```

```cpp
#include <hip/hip_runtime.h>
#include <cstdio>

#define GAS __attribute__((address_space(1)))
#define LAS __attribute__((address_space(3)))
typedef unsigned short bf16;
typedef short bf16x8 __attribute__((ext_vector_type(8)));
typedef float f32x2 __attribute__((ext_vector_type(2)));
typedef float f32x4 __attribute__((ext_vector_type(4)));
typedef float f32x16 __attribute__((ext_vector_type(16)));
typedef unsigned u32x2 __attribute__((ext_vector_type(2)));
typedef unsigned u32x4 __attribute__((ext_vector_type(4)));
typedef int i32x4 __attribute__((ext_vector_type(4)));
typedef int i32x2 __attribute__((ext_vector_type(2)));
typedef int i32x8 __attribute__((ext_vector_type(8)));

constexpr int D = 2048, BATCH = 4, SEQ = 4096, M = BATCH * SEQ, NH = 32, HS = 64;
constexpr int FF0 = 5632, FFE = 7168, NE = 8, LOR = 96, LOG = 256;
constexpr float RMS_EPS = 1e-6f, LNX_EPS = 64e-5f;
constexpr int NCHUNK = M / 64;
constexpr int MAXTILES = 2 * M / 256 + NE;
constexpr int MAXROWS = MAXTILES * 256;

constexpr size_t MiB = (size_t)1 << 20;
constexpr size_t WS_CTL = 0, CTL_ZERO_BYTES = 64 * 1024;
constexpr size_t WS_CNT = 1 * MiB;
constexpr size_t WS_TILEE = WS_CNT + 16 * 1024;
constexpr size_t WS_SEL = WS_CNT + 32 * 1024;
constexpr size_t WS_META = WS_SEL + (size_t)M * 16;
constexpr size_t WS_PART = 256 * 1024;
constexpr size_t WS_POS = WS_META + (size_t)MAXROWS * 8;
constexpr size_t WS_POOLT = 2 * MiB;
constexpr size_t WS_FFN1T = 4 * MiB;
constexpr size_t WS_FFN2T = 48 * MiB;
constexpr size_t WS_RKVLOT = 70 * MiB;
constexpr size_t WS_WOT = 97 * MiB;
constexpr size_t WS_DW2T = 105 * MiB;
constexpr size_t WS_AW2T = WS_DW2T + (size_t)2 * 2048 * 96 * 2;
constexpr size_t WS_G2T = 107 * MiB;
constexpr size_t WS_H = 108 * MiB;
constexpr size_t WS_G = 236 * MiB;
constexpr size_t WS_POOLED = WS_G, WS_HN = WS_G + 64 * MiB, WS_ACT0 = WS_G + 128 * MiB;
constexpr size_t WS_MIX = WS_G;
constexpr size_t WS_RKV = WS_G + 384 * MiB;
constexpr size_t WS_LO = WS_G + 576 * MiB;
constexpr size_t WS_EW = WS_G + 600 * MiB;
constexpr size_t WS_AA = WS_G + 728 * MiB;
constexpr size_t WS_GG = WS_G + 856 * MiB;
constexpr size_t WS_Y = WS_G;
constexpr size_t WS_PO = WS_G + 256 * MiB;
constexpr size_t WS_BS = WS_G + 128 * MiB;
constexpr size_t WS_HN2 = WS_G;
constexpr size_t WS_P2 = WS_G;
constexpr int SPLIT_ROW0 = 128 * 256, KQ = FFE / 4;
constexpr size_t WS_AG = WS_G + 64 * MiB;
constexpr size_t WS_WGUT = WS_G + 920 * MiB;
constexpr size_t WS_WDT = WS_G + 1144 * MiB;
constexpr size_t WS_ACT1 = WS_G + 200 * MiB;
constexpr size_t WS_YM = WS_G + 448 * MiB;
constexpr size_t WS_END = WS_WDT + (size_t)NE * FFE * D;
static_assert(WS_AG + (size_t)MAXROWS * D <= WS_ACT1 && WS_ACT1 + (size_t)MAXROWS * FFE <= WS_YM && WS_YM + (size_t)2 * M * D * 2 <= WS_WGUT && WS_WGUT + (size_t)NE * 2 * FFE * D <= WS_WDT, "moe map");
static_assert(WS_EW + (size_t)2 * M * D * 2 <= WS_AA && WS_AA + (size_t)2 * M * D * 2 <= WS_GG && WS_GG + (size_t)M * D * 2 <= WS_WGUT && WS_END <= (size_t)1600 * MiB, "ws map");
static_assert(WS_PART + (size_t)M * 32 <= WS_CNT && WS_POS + (size_t)M * 8 <= WS_POOLT && WS_G2T + (size_t)2048 * 256 * 2 <= WS_H, "ws small map");

constexpr int LDS_BYTES = 147456;
constexpr int MISC_OFF = LDS_BYTES - 256;

__device__ __forceinline__ float bf2f(unsigned short b) { return __uint_as_float(((unsigned)b) << 16); }
typedef __bf16 bf16v2_t __attribute__((ext_vector_type(2)));
__device__ __forceinline__ unsigned cvt_pk_bf16(float lo, float hi) { const f32x2 v = (f32x2){lo, hi}; return __builtin_bit_cast(unsigned, __builtin_convertvector(v, bf16v2_t)); }
__device__ __forceinline__ void unpk8(const u32x4 w, f32x4& a, f32x4& c) {
    a = (f32x4){__uint_as_float(w.x << 16), __uint_as_float(w.x & 0xffff0000u), __uint_as_float(w.y << 16), __uint_as_float(w.y & 0xffff0000u)};
    c = (f32x4){__uint_as_float(w.z << 16), __uint_as_float(w.z & 0xffff0000u), __uint_as_float(w.w << 16), __uint_as_float(w.w & 0xffff0000u)}; }
__device__ __forceinline__ unsigned pk4_fp8(float a, float b, float c, float d) {
    a = fminf(fmaxf(a, -448.f), 448.f); b = fminf(fmaxf(b, -448.f), 448.f); c = fminf(fmaxf(c, -448.f), 448.f); d = fminf(fmaxf(d, -448.f), 448.f);
    int w = 0; w = __builtin_amdgcn_cvt_pk_fp8_f32(a, b, w, false); w = __builtin_amdgcn_cvt_pk_fp8_f32(c, d, w, true); return (unsigned)w; }
constexpr float F8_SA = 32.f, F8_SWU = 1024.f;
constexpr float F8_SH = 8.f, F8_SWD = 4096.f;
constexpr bool FFN_DOWN_FP8 = false;
constexpr float F8_SH0 = 8.f, F8_SWD0 = 4096.f;
template <int CTRL> __device__ __forceinline__ float dppmov(float v) { return __int_as_float(__builtin_amdgcn_update_dpp(0, __float_as_int(v), CTRL, 0xf, 0xf, true)); }
__device__ __forceinline__ float row16_sum(float v) {
    v += dppmov<0xB1>(v);
    v += dppmov<0x4E>(v);
    v += dppmov<0x141>(v);
    v += dppmov<0x140>(v);
    return v;
}
__device__ __forceinline__ float wave_sum(float v) {
    v = row16_sum(v);
    v += __int_as_float(__builtin_amdgcn_update_dpp(0, __float_as_int(v), 0x142, 0xa, 0xf, false));
    v += __int_as_float(__builtin_amdgcn_update_dpp(0, __float_as_int(v), 0x143, 0xc, 0xf, false));
    return __int_as_float(__builtin_amdgcn_readlane(__float_as_int(v), 63));
}
__device__ __forceinline__ float sigmoidf_(float x) { return __builtin_amdgcn_rcpf(1.0f + __expf(-x)); }
#define LDS_WAIT() asm volatile("s_waitcnt lgkmcnt(0)" ::: "memory")
#define VM_WAIT() asm volatile("s_waitcnt vmcnt(0)" ::: "memory")

namespace pg8 {
constexpr int BM = 256, BK = 64, HALF = 128, HTB = HALF * BK * 2, STAGE_BYTES = 8 * HTB, NXCD = 8, WGM = 4;
__host__ __device__ __forceinline__ int lds_byte(int r, int c) { const int st = (r >> 4) * 2 + (c >> 5), rr = r & 15, cc = c & 31, ob = rr * 64 + cc * 2; return st * 1024 + (ob ^ (((ob >> 9) & 1) << 5)); }
__host__ __device__ __forceinline__ void stage_rc(int b, int& R, int& C) { const int st = b / 1024, sb = b % 1024, swz = sb ^ (((sb >> 9) & 1) << 5); R = (st >> 1) * 16 + swz / 64; C = (st & 1) * 32 + (swz % 64) / 2; }
__host__ __device__ __forceinline__ int perm32(int rho) { const int n = rho >> 4, i = rho & 15; return 8 * (i >> 2) + 4 * n + (i & 3); }

struct Unit { int pm, pn, aux; unsigned long long aoff, boff; };
struct Gemm { const bf16* A; const bf16* Bt; int lda, ldb, K; };

struct TileOrder {
    int nM, nN, nwg, G, c, wgm;
    __device__ __forceinline__ void init(int nM_, int nN_, int G_, int c_, int wgm_ = WGM) { nM = nM_; nN = nN_; nwg = nM * nN; G = G_; c = c_; wgm = wgm_; }
    __device__ __forceinline__ bool map(int i, int& pm, int& pn) const {
        const long L = (long)i * G + c; if (L >= nwg) return false;
        int wgid = (int)L; { const int q = nwg / NXCD, r = nwg % NXCD, xcd = wgid % NXCD, off = wgid / NXCD; wgid = (xcd < r ? xcd * (q + 1) : r * (q + 1) + (xcd - r) * q) + off; }
        const int nig = wgm * nN, gid = wgid / nig, fm = gid * wgm, gsz = (nM - fm) < wgm ? (nM - fm) : wgm;
        pm = fm + ((wgid % nig) % gsz); pn = (wgid % nig) / gsz; return true;
    }
};

template <class Epi, class Sched, bool ALIGN_EPI = true, bool SP2 = true, bool FP8 = false>
__device__ __forceinline__ void gemm_phase(LAS unsigned char* lds, const Gemm g, const Sched& S, const Epi& E) {
    const int tid = threadIdx.x, wid = __builtin_amdgcn_readfirstlane(tid >> 6), lane = tid & 63, wr = wid >> 2, wc = wid & 3, fr = lane & 15, fq = lane >> 4;
    const int K = g.K, nt = K / BK;
    unsigned voffA[2], voffB[2];
#pragma unroll
    for (int i = 0; i < 2; ++i) { int R, C; stage_rc(tid * 16 + i * 8192, R, C); const int Rb = Epi::PERM ? ((R & ~31) + perm32(R & 31)) : R;
        voffA[i] = (unsigned)(R * g.lda + C) * 2u; voffB[i] = (unsigned)(Rb * g.ldb + C) * 2u; }
    const size_t kstep = (size_t)(BK * 2);
    const size_t hstepA = (size_t)HALF * g.lda * 2, hstepB = (size_t)HALF * g.ldb * 2;
    const unsigned ldsw = (unsigned)wid * 1024u;
    const int aoff = lds_byte(wr * 64 + fr, fq * 8), boff = lds_byte(wc * 32 + fr, fq * 8);
#define PG8_SA(b, h) (((b) * 2 + (h)) * HTB)
#define PG8_SB(b, h) ((4 + (b) * 2 + (h)) * HTB)
#define PG8_STAGE(bufoff, gbase, voff) do { _Pragma("unroll") for (int _i = 0; _i < 2; ++_i) \
        __builtin_amdgcn_global_load_lds((const unsigned*)((const char*)(gbase) + (voff)[_i]), (LAS unsigned*)(lds + (bufoff) + ldsw + _i * 8192), 16, 0, 0); } while (0)
#define PG8_LD8(off) __builtin_bit_cast(i32x8, __builtin_shufflevector(*(const LAS u32x4*)(lds + (off)), *(const LAS u32x4*)(lds + (off) + 1024), 0, 1, 2, 3, 4, 5, 6, 7))
#define PG8_LDA(dst, b, h) do { if constexpr (FP8) { _Pragma("unroll") for (int m = 0; m < 4; ++m) dst##8[m] = PG8_LD8(PG8_SA(b, h) + aoff + m * 2048); } \
        else { _Pragma("unroll") for (int m = 0; m < 4; ++m) _Pragma("unroll") for (int k = 0; k < 2; ++k) dst[m][k] = *(const LAS bf16x8*)(lds + PG8_SA(b, h) + aoff + m * 2048 + k * 1024); } } while (0)
#define PG8_LDB(dst, b, h) do { if constexpr (FP8) { _Pragma("unroll") for (int n = 0; n < 2; ++n) dst##8[n] = PG8_LD8(PG8_SB(b, h) + boff + n * 2048); } \
        else { _Pragma("unroll") for (int n = 0; n < 2; ++n) _Pragma("unroll") for (int k = 0; k < 2; ++k) dst[n][k] = *(const LAS bf16x8*)(lds + PG8_SB(b, h) + boff + n * 2048 + k * 1024); } } while (0)
#define PG8_MMA(ai, bj, At, Bt) do { __builtin_amdgcn_s_setprio(1); _Pragma("unroll") for (int m = 0; m < 4; ++m) _Pragma("unroll") for (int n = 0; n < 2; ++n) { \
        if constexpr (FP8) asm volatile("v_mfma_scale_f32_16x16x128_f8f6f4 %0, %1, %2, %0, %3, %3 op_sel_hi:[0,0,0]" : "+v"(acc[ai][bj][m][n]) : "v"(Bt##8[n]), "v"(At##8[m]), "v"(f8scale)); \
        else { _Pragma("unroll") for (int k = 0; k < 2; ++k) acc[ai][bj][m][n] = __builtin_amdgcn_mfma_f32_16x16x32_bf16(Bt[n][k], At[m][k], acc[ai][bj][m][n], 0, 0, 0); } } __builtin_amdgcn_s_setprio(0); } while (0)
#define PG8_WAIT_V(n) asm volatile("s_waitcnt vmcnt(" #n ")" ::: "memory")
#define PG8_WAIT_L(n) asm volatile("s_waitcnt lgkmcnt(" #n ")" ::: "memory")
#define PG8_BAR __builtin_amdgcn_s_barrier()
#define PG8_SCHED __builtin_amdgcn_sched_barrier(0)
    Unit cur, nxt; int ui = 0;
    if (!S.next(0, cur)) return;
    f32x4 acc[2][2][4][2];
#pragma unroll
    for (int a = 0; a < 2; ++a)
#pragma unroll
        for (int b = 0; b < 2; ++b)
#pragma unroll
            for (int m = 0; m < 4; ++m)
#pragma unroll
                for (int n = 0; n < 2; ++n) acc[a][b][m][n] = (f32x4){0.f, 0.f, 0.f, 0.f};
    bf16x8 At[4][2], B0[2][2], B1[2][2]; i32x8 At8[4], B08[2], B18[2];
    const int f8scale = 0x7f7f7f7f;
    const char* cA = (const char*)g.A + cur.aoff; const char* cB = (const char*)g.Bt + cur.boff;
    if constexpr (SP2) {
        PG8_STAGE(PG8_SB(0, 0), cB, voffB); PG8_STAGE(PG8_SB(0, 1), cB + hstepB, voffB); PG8_STAGE(PG8_SA(0, 0), cA, voffA); PG8_STAGE(PG8_SA(0, 1), cA + hstepA, voffA);
        if (wr == 1) PG8_BAR;
        PG8_WAIT_V(2); PG8_BAR;
        PG8_STAGE(PG8_SB(1, 0), cB + kstep, voffB); PG8_STAGE(PG8_SA(1, 0), cA + kstep, voffA); PG8_STAGE(PG8_SB(1, 1), cB + hstepB + kstep, voffB);
        PG8_WAIT_V(6); PG8_BAR;
    } else {
        PG8_STAGE(PG8_SB(0, 0), cB, voffB); PG8_STAGE(PG8_SA(0, 0), cA, voffA); PG8_STAGE(PG8_SB(0, 1), cB + hstepB, voffB); PG8_STAGE(PG8_SA(0, 1), cA + hstepA, voffA);
        if (wr == 1) PG8_BAR;
        PG8_WAIT_V(4); PG8_BAR;
        PG8_STAGE(PG8_SB(1, 0), cB + kstep, voffB); PG8_STAGE(PG8_SA(1, 0), cA + kstep, voffA); PG8_STAGE(PG8_SB(1, 1), cB + hstepB + kstep, voffB);
        PG8_WAIT_V(6); PG8_BAR;
    }
    for (;;) {
        const bool has_next = S.next(ui + 1, nxt);
        const char* nA = has_next ? (const char*)g.A + nxt.aoff : cA; const char* nB = has_next ? (const char*)g.Bt + nxt.boff : cB;
        for (int t = 0; t < nt; t += 2) {
            const bool last = (t == nt - 2);
            const char* a1 = cA + (size_t)(t + 1) * kstep;
            const char* a2 = last ? nA : cA + (size_t)(t + 2) * kstep; const char* b2 = last ? nB : cB + (size_t)(t + 2) * kstep;
            const char* a3 = a2 + kstep; const char* b3 = b2 + kstep;
            if constexpr (SP2) {
            PG8_LDB(B0, 0, 0); PG8_LDB(B1, 0, 1); PG8_SCHED; PG8_LDA(At, 0, 0); PG8_STAGE(PG8_SA(1, 1), a1 + hstepA, voffA);
            PG8_WAIT_V(8); PG8_WAIT_L(0); PG8_BAR; PG8_MMA(0, 0, At, B0); PG8_MMA(0, 1, At, B1); PG8_BAR; PG8_SCHED;
            PG8_LDA(At, 0, 1); PG8_STAGE(PG8_SB(0, 0), b2, voffB); PG8_STAGE(PG8_SB(0, 1), b2 + hstepB, voffB); PG8_STAGE(PG8_SA(0, 0), a2, voffA);
            PG8_WAIT_V(8); PG8_WAIT_L(0); PG8_BAR; PG8_MMA(1, 0, At, B0); PG8_MMA(1, 1, At, B1); PG8_BAR; PG8_SCHED;
            PG8_LDB(B0, 1, 0); PG8_LDB(B1, 1, 1); PG8_SCHED; PG8_LDA(At, 1, 0); PG8_STAGE(PG8_SA(0, 1), a2 + hstepA, voffA);
            PG8_WAIT_V(8); PG8_WAIT_L(0); PG8_BAR; PG8_MMA(0, 0, At, B0); PG8_MMA(0, 1, At, B1); PG8_BAR; PG8_SCHED;
            PG8_LDA(At, 1, 1); PG8_STAGE(PG8_SB(1, 0), b3, voffB); PG8_STAGE(PG8_SB(1, 1), b3 + hstepB, voffB); PG8_STAGE(PG8_SA(1, 0), a3, voffA);
            PG8_WAIT_V(8); PG8_WAIT_L(0); PG8_BAR; PG8_MMA(1, 0, At, B0); PG8_MMA(1, 1, At, B1); PG8_BAR; PG8_SCHED;
            } else {
            PG8_LDB(B0, 0, 0); PG8_SCHED; PG8_LDA(At, 0, 0); PG8_STAGE(PG8_SA(1, 1), a1 + hstepA, voffA);
            PG8_WAIT_L(8); PG8_BAR; PG8_WAIT_L(0); PG8_MMA(0, 0, At, B0); PG8_BAR; PG8_SCHED;
            PG8_LDB(B1, 0, 1); PG8_STAGE(PG8_SB(0, 0), b2, voffB);
            PG8_BAR; PG8_WAIT_L(0); PG8_MMA(0, 1, At, B1); PG8_BAR;
            PG8_LDA(At, 0, 1); PG8_STAGE(PG8_SA(0, 0), a2, voffA);
            PG8_BAR; PG8_WAIT_L(0); PG8_MMA(1, 0, At, B0); PG8_BAR; PG8_SCHED;
            PG8_STAGE(PG8_SB(0, 1), b2 + hstepB, voffB);
            PG8_WAIT_V(6); PG8_BAR; PG8_MMA(1, 1, At, B1); PG8_BAR;
            PG8_LDB(B0, 1, 0); PG8_SCHED; PG8_LDA(At, 1, 0); PG8_STAGE(PG8_SA(0, 1), a2 + hstepA, voffA);
            PG8_WAIT_L(8); PG8_BAR; PG8_WAIT_L(0); PG8_MMA(0, 0, At, B0); PG8_BAR; PG8_SCHED;
            PG8_LDB(B1, 1, 1); PG8_STAGE(PG8_SB(1, 0), b3, voffB);
            PG8_BAR; PG8_WAIT_L(0); PG8_MMA(0, 1, At, B1); PG8_BAR;
            PG8_LDA(At, 1, 1); PG8_STAGE(PG8_SA(1, 0), a3, voffA);
            PG8_BAR; PG8_WAIT_L(0); PG8_MMA(1, 0, At, B0); PG8_BAR; PG8_SCHED;
            PG8_STAGE(PG8_SB(1, 1), b3 + hstepB, voffB);
            PG8_WAIT_V(6); PG8_BAR; PG8_MMA(1, 1, At, B1); PG8_BAR;
            }
        }
        if constexpr (ALIGN_EPI) { if (wr == 0) PG8_BAR; }
        if constexpr (FP8) {
            asm volatile("s_nop 15\n\ts_nop 3" ::: "memory");
#pragma unroll
            for (int a = 0; a < 2; ++a)
#pragma unroll
                for (int b = 0; b < 2; ++b)
#pragma unroll
                    for (int m = 0; m < 4; ++m)
#pragma unroll
                        for (int n = 0; n < 2; ++n) asm volatile("" : "+v"(acc[a][b][m][n])); }
        E(acc, cur, wr, wc, fr, fq);
        if (!has_next) break;
#pragma unroll
        for (int a = 0; a < 2; ++a)
#pragma unroll
            for (int b = 0; b < 2; ++b)
#pragma unroll
                for (int m = 0; m < 4; ++m)
#pragma unroll
                    for (int n = 0; n < 2; ++n) acc[a][b][m][n] = (f32x4){0.f, 0.f, 0.f, 0.f};
        cur = nxt; cA = nA; cB = nB; ++ui;
        if constexpr (ALIGN_EPI) { if (wr == 1) PG8_BAR; }
    }
    PG8_WAIT_V(0);
    if constexpr (!ALIGN_EPI) { if (wr == 0) PG8_BAR; }
    PG8_BAR;
#undef PG8_SA
#undef PG8_SB
#undef PG8_STAGE
#undef PG8_LDA
#undef PG8_LDB
#undef PG8_MMA
#undef PG8_LD8
#undef PG8_WAIT_V
#undef PG8_WAIT_L
#undef PG8_BAR
#undef PG8_SCHED
}

struct EpiPool {
    static constexpr bool PERM = true;
    const float* X; bf16* Hh; const float* scale; LAS float* red; float* part;
    __device__ __forceinline__ void operator()(const f32x4 (&acc)[2][2][4][2], const Unit& u, int wr, int wc, int fr, int fq) const {
        const int row0 = u.pm * BM + wr * 64 + fr, col0 = u.pn * BM + wc * 32 + 8 * fq;
        float ss[2][4];
        f32x4 sv[2][2];
#pragma unroll
        for (int bj = 0; bj < 2; ++bj)
#pragma unroll
            for (int n = 0; n < 2; ++n) sv[bj][n] = *(const GAS f32x4*)(scale + col0 + bj * HALF + 4 * n);
#pragma unroll
        for (int ai = 0; ai < 2; ++ai)
#pragma unroll
            for (int m = 0; m < 4; ++m) { const size_t off = (size_t)(row0 + ai * HALF + m * 16) * D + col0; float sq = 0.f;
#pragma unroll
                for (int bj = 0; bj < 2; ++bj) { const f32x4 x0 = __builtin_nontemporal_load((const GAS f32x4*)(X + off + bj * HALF)), x1 = __builtin_nontemporal_load((const GAS f32x4*)(X + off + bj * HALF + 4));
                    const f32x4 v0 = x0 + acc[ai][bj][m][0] * sv[bj][0], v1 = x1 + acc[ai][bj][m][1] * sv[bj][1];
                    const f32x4 q = v0 * v0 + v1 * v1; sq += (q[0] + q[1]) + (q[2] + q[3]);
                    *(GAS u32x4*)(Hh + off + bj * HALF) = (u32x4){cvt_pk_bf16(v0[0], v0[1]), cvt_pk_bf16(v0[2], v0[3]), cvt_pk_bf16(v1[0], v1[1]), cvt_pk_bf16(v1[2], v1[3])}; }
                ss[ai][m] = sq;
                asm volatile("" ::: "memory"); }
#pragma unroll
        for (int ai = 0; ai < 2; ++ai)
#pragma unroll
            for (int m = 0; m < 4; ++m) { float v = ss[ai][m]; v += __shfl_xor(v, 16); v += __shfl_xor(v, 32); if (fq == 0) red[(ai * HALF + wr * 64 + m * 16 + fr) * 4 + wc] = v; }
        __syncthreads();
        { const int t = (int)threadIdx.x; if (t < BM) { const f32x4 r4 = *(LAS f32x4*)(red + t * 4); part[(size_t)(u.pm * BM + t) * 8 + u.pn] = (r4[0] + r4[1]) + (r4[2] + r4[3]); } }
        __syncthreads();
    }
};
struct EpiResid {
    static constexpr bool PERM = true;
    bf16* Hh; float post = 1.0f;
    __device__ __forceinline__ void operator()(const f32x4 (&acc)[2][2][4][2], const Unit& u, int wr, int wc, int fr, int fq) const {
        const int row0 = u.pm * BM + wr * 64 + fr, col0 = u.pn * BM + wc * 32 + 8 * fq;
#pragma unroll
        for (int ai = 0; ai < 2; ++ai)
#pragma unroll
            for (int m = 0; m < 4; ++m) { GAS bf16* rowp = (GAS bf16*)Hh + (size_t)(row0 + ai * HALF + m * 16) * D + col0;
#pragma unroll
                for (int bj = 0; bj < 2; ++bj) { f32x4 h0, h1; unpk8(*(const GAS u32x4*)(rowp + bj * HALF), h0, h1);
                    const f32x4 v0 = h0 + acc[ai][bj][m][0] * post, v1 = h1 + acc[ai][bj][m][1] * post;
                    *(GAS u32x4*)(rowp + bj * HALF) = (u32x4){cvt_pk_bf16(v0[0], v0[1]), cvt_pk_bf16(v0[2], v0[3]), cvt_pk_bf16(v1[0], v1[1]), cvt_pk_bf16(v1[2], v1[3])}; }
                asm volatile("" ::: "memory"); }
    }
};
struct EpiSwiglu {
    static constexpr bool PERM = true;
    bf16* O; int ldo; const float* part;
    __device__ __forceinline__ void operator()(const f32x4 (&acc)[2][2][4][2], const Unit& u, int wr, int wc, int fr, int fq) const {
        const int row0 = u.pm * BM + wr * 64 + fr, col0 = u.pn * HALF + wc * 32 + 8 * fq;
#pragma unroll
        for (int ai = 0; ai < 2; ++ai)
#pragma unroll
            for (int m = 0; m < 4; ++m) {
                float rsv; { const GAS f32x4* pp = (const GAS f32x4*)(part + (size_t)(row0 + ai * HALF + m * 16) * 8); const f32x4 p0 = pp[0], p1 = pp[1]; rsv = 1.0f / sqrtf((((p0[0] + p0[1]) + (p0[2] + p0[3])) + ((p1[0] + p1[1]) + (p1[2] + p1[3]))) * (1.0f / D) + RMS_EPS); }
                float o[8];
#pragma unroll
                for (int n = 0; n < 2; ++n)
#pragma unroll
                    for (int j = 0; j < 4; ++j) { const float gt = acc[ai][0][m][n][j] * rsv, up = acc[ai][1][m][n][j] * rsv; o[4 * n + j] = gt * sigmoidf_(gt) * up; }
                u32x4 w; w.x = cvt_pk_bf16(o[0], o[1]); w.y = cvt_pk_bf16(o[2], o[3]); w.z = cvt_pk_bf16(o[4], o[5]); w.w = cvt_pk_bf16(o[6], o[7]);
                *(GAS u32x4*)(O + (size_t)(row0 + ai * HALF + m * 16) * ldo + col0) = w; }
    }
};
struct EpiSwigluF8 {
    static constexpr bool PERM = true;
    unsigned char* O; int ldo; float pre;
    __device__ __forceinline__ void operator()(const f32x4 (&acc)[2][2][4][2], const Unit& u, int wr, int wc, int fr, int fq) const {
        const int row0 = u.pm * BM + wr * 64 + fr, col0 = u.pn * HALF + wc * 32 + 8 * fq;
        const float c_e = -1.44269504f * pre, c_gu = pre * pre * F8_SH;
#pragma unroll
        for (int ai = 0; ai < 2; ++ai)
#pragma unroll
            for (int m = 0; m < 4; ++m) {
                float o[8];
#pragma unroll
                for (int n = 0; n < 2; ++n)
#pragma unroll
                    for (int j = 0; j < 4; ++j) { const float ga = acc[ai][0][m][n][j], ua = acc[ai][1][m][n][j];
                        const float sg = __builtin_amdgcn_rcpf(1.0f + __builtin_amdgcn_exp2f(ga * c_e));
                        o[4 * n + j] = __builtin_amdgcn_fmed3f(ga * sg * (ua * c_gu), -448.f, 448.f); }
                int w0 = 0, w1 = 0;
                w0 = __builtin_amdgcn_cvt_pk_fp8_f32(o[0], o[1], w0, false); w0 = __builtin_amdgcn_cvt_pk_fp8_f32(o[2], o[3], w0, true);
                w1 = __builtin_amdgcn_cvt_pk_fp8_f32(o[4], o[5], w1, false); w1 = __builtin_amdgcn_cvt_pk_fp8_f32(o[6], o[7], w1, true);
                *(GAS u32x2*)(O + (size_t)(row0 + ai * HALF + m * 16) * ldo + col0) = (u32x2){(unsigned)w0, (unsigned)w1}; }
    }
};
struct EpiSwigluF8R {
    static constexpr bool PERM = true;
    unsigned char* O; int ldo; float osc; const float* part;
    __device__ __forceinline__ void operator()(const f32x4 (&acc)[2][2][4][2], const Unit& u, int wr, int wc, int fr, int fq) const {
        const int row0 = u.pm * BM + wr * 64 + fr, col0 = u.pn * HALF + wc * 32 + 8 * fq;
#pragma unroll
        for (int ai = 0; ai < 2; ++ai)
#pragma unroll
            for (int m = 0; m < 4; ++m) {
                float rsv; { const GAS f32x4* pp = (const GAS f32x4*)(part + (size_t)(row0 + ai * HALF + m * 16) * 8); const f32x4 p0 = pp[0], p1 = pp[1]; rsv = 1.0f / sqrtf((((p0[0] + p0[1]) + (p0[2] + p0[3])) + ((p1[0] + p1[1]) + (p1[2] + p1[3]))) * (1.0f / D) + RMS_EPS); }
                const float c_e = -1.44269504f * rsv, c_gu = rsv * rsv * osc;
                float o[8];
#pragma unroll
                for (int n = 0; n < 2; ++n)
#pragma unroll
                    for (int j = 0; j < 4; ++j) { const float ga = acc[ai][0][m][n][j], ua = acc[ai][1][m][n][j];
                        const float sg = __builtin_amdgcn_rcpf(1.0f + __builtin_amdgcn_exp2f(ga * c_e));
                        o[4 * n + j] = __builtin_amdgcn_fmed3f(ga * sg * (ua * c_gu), -448.f, 448.f); }
                int w0 = 0, w1 = 0;
                w0 = __builtin_amdgcn_cvt_pk_fp8_f32(o[0], o[1], w0, false); w0 = __builtin_amdgcn_cvt_pk_fp8_f32(o[2], o[3], w0, true);
                w1 = __builtin_amdgcn_cvt_pk_fp8_f32(o[4], o[5], w1, false); w1 = __builtin_amdgcn_cvt_pk_fp8_f32(o[6], o[7], w1, true);
                *(GAS u32x2*)(O + (size_t)(row0 + ai * HALF + m * 16) * ldo + col0) = (u32x2){(unsigned)w0, (unsigned)w1}; }
    }
};
struct EpiRkvLo {
    static constexpr bool PERM = true;
    bf16* RKV; bf16* LO;
    __device__ __forceinline__ void operator()(const f32x4 (&acc)[2][2][4][2], const Unit& u, int wr, int wc, int fr, int fq) const {
        const int row0 = u.pm * BM + wr * 64 + fr; const int aux = u.aux;
        bf16* base; int ldo;
        if (aux < 3) { base = RKV + (size_t)aux * M * D + u.pn * BM; ldo = D; } else { base = LO + (size_t)(aux - 3) * M * 256; ldo = 256; }
        base += wc * 32 + 8 * fq;
#pragma unroll
        for (int ai = 0; ai < 2; ++ai)
#pragma unroll
            for (int m = 0; m < 4; ++m) { bf16* rowp = base + (size_t)(row0 + ai * HALF + m * 16) * ldo;
#pragma unroll
                for (int bj = 0; bj < 2; ++bj) { f32x4 v0 = acc[ai][bj][m][0], v1 = acc[ai][bj][m][1];
                    if (aux == 3) {
#pragma unroll
                        for (int j = 0; j < 4; ++j) { v0[j] = 1.0f - 2.0f * __builtin_amdgcn_rcpf(1.0f + __expf(2.0f * v0[j])); v1[j] = 1.0f - 2.0f * __builtin_amdgcn_rcpf(1.0f + __expf(2.0f * v1[j])); } }
                    else if (aux == 5) {
#pragma unroll
                        for (int j = 0; j < 4; ++j) { v0[j] = sigmoidf_(v0[j]); v1[j] = sigmoidf_(v1[j]); } }
                    u32x4 w; w.x = cvt_pk_bf16(v0[0], v0[1]); w.y = cvt_pk_bf16(v0[2], v0[3]); w.z = cvt_pk_bf16(v1[0], v1[1]); w.w = cvt_pk_bf16(v1[2], v1[3]);
                    *(GAS u32x4*)(rowp + bj * HALF) = w; } }
    }
};
struct EpiMoeDown {
    static constexpr bool PERM = true;
    const i32x2* meta; bf16* Y; bf16* P2; float post;
    __device__ __forceinline__ void operator()(const f32x4 (&acc)[2][2][4][2], const Unit& u, int wr, int wc, int fr, int fq) const {
        const int row0 = u.pm * BM + wr * 64 + fr, col0 = u.pn * BM + wc * 32 + 8 * fq;
#pragma unroll
        for (int ai = 0; ai < 2; ++ai)
#pragma unroll
            for (int m = 0; m < 4; ++m) { const i32x2 mt = *(const GAS i32x2*)(meta + row0 + ai * HALF + m * 16);
                if (mt.x >= 0) { const int tok = mt.x & 0x3fff, slot = (mt.x >> 14) & 1; const float gt = __int_as_float(mt.y) * post;
                    GAS bf16* rowp = (u.aux == 0) ? (GAS bf16*)Y + ((size_t)slot * M + tok) * D + col0 : (GAS bf16*)P2 + ((size_t)(u.aux - 1) * 2048 + (row0 + ai * HALF + m * 16 - 32768)) * D + col0;
#pragma unroll
                    for (int bj = 0; bj < 2; ++bj) { const f32x4 v0 = acc[ai][bj][m][0] * gt, v1 = acc[ai][bj][m][1] * gt;
                        *(GAS u32x4*)(rowp + bj * HALF) = (u32x4){cvt_pk_bf16(v0[0], v0[1]), cvt_pk_bf16(v0[2], v0[3]), cvt_pk_bf16(v1[0], v1[1]), cvt_pk_bf16(v1[2], v1[3])}; } } }
    }
};
}

#define XB_TMO      128
#define XB_XCNT(j)  (256  + 64 * (j))
#define XB_XSUB(j)  (1280 + 64 * (j))
#define XB_XGEN(j)  (2304 + 64 * (j))
#define XB_TOP      3328
#define XB_TOPGEN   3392
#define XCD_BAR_WORDS 3456
#define XB_SPIN_CAP (1u << 18)
__device__ __forceinline__ unsigned xb_ld(unsigned* p)              { return __hip_atomic_load(p, __ATOMIC_RELAXED, __HIP_MEMORY_SCOPE_AGENT); }
__device__ __forceinline__ unsigned xb_add(unsigned* p, unsigned v) { return __hip_atomic_fetch_add(p, v, __ATOMIC_RELAXED, __HIP_MEMORY_SCOPE_AGENT); }
__device__ __forceinline__ unsigned xb_xcc_id() { return (unsigned)__builtin_amdgcn_s_getreg((3 << 11) | 20) & 0xFu; }
#define XB_SPIN(cond, bar) do { unsigned _sp = 0; while (cond) { __builtin_amdgcn_s_sleep(1); \
    if ((++_sp & 255u) == 0u) { if (xb_ld(&(bar)[XB_TMO])) break; if (_sp > XB_SPIN_CAP) { atomicAdd(&(bar)[XB_TMO], 1u); break; } } } } while (0)
struct XcdBarrier { unsigned* bar; unsigned x; volatile LAS unsigned* st; };
__device__ __forceinline__ XcdBarrier xcd_barrier_post(unsigned* bar, volatile LAS unsigned* st) {
    XcdBarrier b; b.bar = bar; b.x = xb_xcc_id(); b.st = st;
    if (threadIdx.x == 0) (void)xb_add(&bar[XB_XCNT(b.x)], 1u);
    return b;
}
__device__ __forceinline__ void xcd_barrier_complete(unsigned* bar, unsigned x, unsigned& nloc, unsigned& nx) {
    const unsigned G = gridDim.x * gridDim.y * gridDim.z;
    unsigned sum, cnt, mine, sp = 0u;
    for (;;) {
        sum = 0u; cnt = 0u; mine = 0u;
#pragma unroll
        for (unsigned j = 0; j < 16; ++j) { const unsigned c = xb_ld(&bar[XB_XCNT(j)]); sum += c; cnt += (c > 0u) ? 1u : 0u; mine = (j == x) ? c : mine; }
        if (sum == G) break;
        __builtin_amdgcn_s_sleep(1);
        if ((++sp & 255u) == 0u) { if (xb_ld(&bar[XB_TMO])) break; if (sp > XB_SPIN_CAP) { atomicAdd(&bar[XB_TMO], 1u); break; } }
    }
    nloc = mine > 0u ? mine : 1u; nx = cnt > 0u ? cnt : 1u;
}
__device__ __forceinline__ void xcd_barrier(const XcdBarrier& b) {
    asm volatile("s_waitcnt vmcnt(0)" ::: "memory");
    __syncthreads();
    if (threadIdx.x == 0) {
        unsigned* bar = b.bar;
        __builtin_amdgcn_s_waitcnt(0);
        unsigned nloc = b.st[0], nx = b.st[1];
        if (nloc == 0u) { xcd_barrier_complete(bar, b.x, nloc, nx); b.st[0] = nloc; b.st[1] = nx; }
        const unsigned old = xb_add(&bar[XB_XSUB(b.x)], 1u);
        const unsigned gen = old / nloc;
        if (old + 1u == (gen + 1u) * nloc) {
            __builtin_amdgcn_fence(__ATOMIC_RELEASE, "agent");
            asm volatile("s_waitcnt vmcnt(0)" ::: "memory");
            const unsigned og = xb_add(&bar[XB_TOP], 1u);
            const unsigned tg = og / nx;
            if (og + 1u == (tg + 1u) * nx) xb_add(&bar[XB_TOPGEN], 1u);
            else XB_SPIN(xb_ld(&bar[XB_TOPGEN]) == tg, bar);
            __builtin_amdgcn_fence(__ATOMIC_ACQUIRE, "agent");
            xb_add(&bar[XB_XGEN(b.x)], 1u);
            asm volatile("s_waitcnt vmcnt(0)" ::: "memory");
        } else {
            XB_SPIN(xb_ld(&bar[XB_XGEN(b.x)]) == gen, bar);
            __builtin_amdgcn_fence(__ATOMIC_ACQUIRE, "agent");
            asm volatile("s_waitcnt vmcnt(0)" ::: "memory");
        }
    }
    __syncthreads();
}

struct SchedPlain {
    pg8::TileOrder T; unsigned long long astep, bstep;
    __device__ __forceinline__ bool next(int i, pg8::Unit& u) const { int pm, pn; if (!T.map(i, pm, pn)) return false; u.pm = pm; u.pn = pn; u.aux = 0; u.aoff = (unsigned long long)pm * astep; u.boff = (unsigned long long)pn * bstep; return true; }
};
struct SchedPool {
    pg8::TileOrder T;
    __device__ __forceinline__ bool next(int i, pg8::Unit& u) const { int pm, pn; if (!T.map(i, pm, pn)) return false; u.pm = pm; u.pn = pn; u.aux = 0;
        u.aoff = (unsigned long long)pm * 256 * D * 2 + (unsigned long long)(pn >> 1) * 512 * 2; u.boff = (unsigned long long)pn * 256 * 512 * 2; return true; }
};
struct SchedRkvLo {
    pg8::TileOrder T;
    __device__ __forceinline__ bool next(int i, pg8::Unit& u) const { int pm, pn; if (!T.map(i, pm, pn)) return false; u.pm = pm;
        int amat;
        if (pn < 24) { const int w = pn >> 3; u.aux = w; u.pn = pn & 7; amat = (w == 0) ? 0 : (w == 1 ? 2 : 3); }
        else { const int q = pn - 24; u.aux = 3 + q; u.pn = 0; amat = (q == 0) ? 1 : (q == 1 ? 4 : 5); }
        u.aoff = ((unsigned long long)amat * M + (unsigned long long)pm * 256) * D * 2; u.boff = (unsigned long long)pn * 256 * D * 2; return true; }
};
struct SchedMoe {
    pg8::TileOrder T; const LAS unsigned* tile_e; unsigned long long astep, bstep; int nN;
    __device__ __forceinline__ bool next(int i, pg8::Unit& u) const { int pm, pn; if (!T.map(i, pm, pn)) return false; u.pm = pm; u.pn = pn; u.aux = 0;
        const int e = (int)__builtin_amdgcn_readfirstlane(tile_e[pm]) & 7;
        u.aoff = (unsigned long long)pm * astep; u.boff = (unsigned long long)(e * nN + pn) * bstep; return true; }
};

constexpr int REP3 = 1, REP6 = 1, REP7 = 1, REP8 = 1, REP9 = 1, REP11 = 1, REP13 = 1, REP14 = 1, REP0 = 1, REP2 = 1, REP5 = 1, REP12 = 1, REP15 = 1;
struct SchedMoeTail {
    int nq, G, c; const LAS unsigned* tile_e;
    __device__ __forceinline__ bool next(int i, pg8::Unit& u) const { const int L = i * G + c; if (L >= nq) return false; const int kq = L & 3, uu = L >> 2, pm = 128 + (uu >> 3), pn = uu & 7;
        const int e = (int)__builtin_amdgcn_readfirstlane(tile_e[pm]) & 7;
        u.pm = pm; u.pn = pn; u.aux = kq; u.aoff = (unsigned long long)pm * 256 * FFE + (unsigned long long)kq * KQ; u.boff = (unsigned long long)(e * 8 + pn) * 256 * FFE + (unsigned long long)kq * KQ; return true; }
};
struct Params { const float* in[33]; float* out; unsigned char* ws; int ph_lo, ph_hi; };

template <bool NTS = false>
__device__ __forceinline__ void tr_tile(const float* W, int N, int k0, int n0, bf16* WT, size_t drow0, int ldd, LAS float* scr, int lane, const float* kscale = nullptr) {
    const int kq = lane >> 4, n4 = (lane & 15) * 4;
    f32x4 v[16];
#pragma unroll
    for (int i = 0; i < 16; ++i) v[i] = __builtin_nontemporal_load((const GAS f32x4*)(W + (size_t)(k0 + 4 * i + kq) * N + n0 + n4));
    if (kscale) {
#pragma unroll
        for (int i = 0; i < 16; ++i) v[i] = v[i] * kscale[k0 + 4 * i + kq]; }
#pragma unroll
    for (int i = 0; i < 16; ++i) { LAS float* s = scr + (4 * i + kq) * 65 + n4; s[0] = v[i].x; s[1] = v[i].y; s[2] = v[i].z; s[3] = v[i].w; }
    LDS_WAIT(); asm volatile("" ::: "memory");
    const int c = lane & 7;
#pragma unroll
    for (int p = 0; p < 8; ++p) { const int n = (lane >> 3) + 8 * p; const LAS float* s = scr + (8 * c) * 65 + n;
        u32x4 o; o.x = cvt_pk_bf16(s[0], s[65]); o.y = cvt_pk_bf16(s[2 * 65], s[3 * 65]); o.z = cvt_pk_bf16(s[4 * 65], s[5 * 65]); o.w = cvt_pk_bf16(s[6 * 65], s[7 * 65]);
        if (NTS) __builtin_nontemporal_store(o, (GAS u32x4*)(WT + (drow0 + n) * ldd + k0 + 8 * c)); else *(GAS u32x4*)(WT + (drow0 + n) * ldd + k0 + 8 * c) = o; }
    LDS_WAIT(); asm volatile("" ::: "memory");
}
__device__ __forceinline__ void cv8_load(const float* W, int N, int k0, int n0, f32x4 (&v)[16], int lane) {
    const int kq = lane >> 4, n4 = (lane & 15) * 4;
#pragma unroll
    for (int i = 0; i < 16; ++i) v[i] = __builtin_nontemporal_load((const GAS f32x4*)(W + (size_t)(k0 + 16 * kq + i) * N + n0 + n4));
}
__device__ __forceinline__ void cv8_store(const f32x4 (&v)[16], int k0, unsigned char* WT, size_t drow0, int ldd, float sc, int lane) {
    const int kq = lane >> 4, n4 = (lane & 15) * 4;
#pragma unroll
    for (int e = 0; e < 4; ++e) { u32x4 o;
#pragma unroll
        for (int d = 0; d < 4; ++d) { int w = 0;
            w = __builtin_amdgcn_cvt_pk_fp8_f32(__builtin_amdgcn_fmed3f(v[4 * d][e] * sc, -448.f, 448.f), __builtin_amdgcn_fmed3f(v[4 * d + 1][e] * sc, -448.f, 448.f), w, false);
            w = __builtin_amdgcn_cvt_pk_fp8_f32(__builtin_amdgcn_fmed3f(v[4 * d + 2][e] * sc, -448.f, 448.f), __builtin_amdgcn_fmed3f(v[4 * d + 3][e] * sc, -448.f, 448.f), w, true);
            o[d] = (unsigned)w; }
        __builtin_nontemporal_store(o, (GAS u32x4*)(WT + (drow0 + n4 + e) * ldd + k0 + 16 * kq)); }
}
constexpr int MOE_T_E = 32 * 112, MOE_NT = NE * 3 * MOE_T_E;
__device__ __forceinline__ void moe_cvh_load(const float* const* in, int it, int h, f32x2 (&v)[16], int lane) {
    const int e = it / (3 * MOE_T_E), r3 = it % (3 * MOE_T_E), which = r3 / MOE_T_E, t = r3 % MOE_T_E;
    const int kq = lane >> 4, n2 = (lane & 15) * 2 + 32 * h;
    const float* W; int N, k0, n0;
    if (which < 2) { W = in[29 + which] + (size_t)e * D * FFE; N = FFE; k0 = 64 * (t / 112); n0 = 64 * (t % 112); } else { W = in[31] + (size_t)e * FFE * D; N = D; k0 = 64 * (t / 32); n0 = 64 * (t % 32); }
#pragma unroll
    for (int i = 0; i < 16; ++i) v[i] = __builtin_nontemporal_load((const GAS f32x2*)(W + (size_t)(k0 + 16 * kq + i) * N + n0 + n2));
}
__device__ __forceinline__ void moe_cvh_store(unsigned char* ws, int it, int h, const f32x2 (&v)[16], int lane) {
    const int e = it / (3 * MOE_T_E), r3 = it % (3 * MOE_T_E), which = r3 / MOE_T_E, t = r3 % MOE_T_E;
    const int kq = lane >> 4, n2 = (lane & 15) * 2 + 32 * h;
    unsigned char* WT; size_t drow0; int ldd, k0; float sc;
    if (which < 2) { const int nb2 = t % 112; WT = ws + WS_WGUT; drow0 = (size_t)e * 2 * FFE + (size_t)((64 * nb2) >> 7) * 256 + 128 * which + ((64 * nb2) & 127); ldd = D; k0 = 64 * (t / 112); sc = F8_SWU; }
    else { WT = ws + WS_WDT; drow0 = (size_t)e * D + 64 * (t % 32); ldd = FFE; k0 = 64 * (t / 32); sc = F8_SWD; }
#pragma unroll
    for (int e2 = 0; e2 < 2; ++e2) { u32x4 o;
#pragma unroll
        for (int d = 0; d < 4; ++d) { int w = 0;
            w = __builtin_amdgcn_cvt_pk_fp8_f32(__builtin_amdgcn_fmed3f(v[4 * d][e2] * sc, -448.f, 448.f), __builtin_amdgcn_fmed3f(v[4 * d + 1][e2] * sc, -448.f, 448.f), w, false);
            w = __builtin_amdgcn_cvt_pk_fp8_f32(__builtin_amdgcn_fmed3f(v[4 * d + 2][e2] * sc, -448.f, 448.f), __builtin_amdgcn_fmed3f(v[4 * d + 3][e2] * sc, -448.f, 448.f), w, true);
            o[d] = (unsigned)w; }
        __builtin_nontemporal_store(o, (GAS u32x4*)(WT + (drow0 + n2 + e2) * ldd + k0 + 16 * kq)); }
}
constexpr int CVW0 = 4, NCW = 8 - CVW0, MOE_CV_EARLY = (SEQ / 64) * NCW * 256;
constexpr int MOE_CV_HALVES = 2 * (MOE_NT - MOE_CV_EARLY);
static_assert(MOE_CV_HALVES <= (SEQ / 64) * 3 * 256, "half-item slots");
static_assert(MOE_CV_EARLY <= MOE_NT && 2 * BATCH * NH == 256, "early weight-copy items are indexed by the 256 scan workgroups");
__device__ __forceinline__ void moe_cv_load(const float* const* in, int it, f32x4 (&v)[16], int lane) {
    const int e = it / (3 * MOE_T_E), r3 = it % (3 * MOE_T_E), which = r3 / MOE_T_E, t = r3 % MOE_T_E;
    if (which < 2) cv8_load(in[29 + which] + (size_t)e * D * FFE, FFE, 64 * (t / 112), 64 * (t % 112), v, lane);
    else cv8_load(in[31] + (size_t)e * FFE * D, D, 64 * (t / 32), 64 * (t % 32), v, lane);
}
__device__ __forceinline__ void moe_cv_store(unsigned char* ws, int it, const f32x4 (&v)[16], int lane) {
    const int e = it / (3 * MOE_T_E), r3 = it % (3 * MOE_T_E), which = r3 / MOE_T_E, t = r3 % MOE_T_E;
    if (which < 2) { const int nb2 = t % 112; cv8_store(v, 64 * (t / 112), ws + WS_WGUT, (size_t)e * 2 * FFE + (size_t)((64 * nb2) >> 7) * 256 + 128 * which + ((64 * nb2) & 127), D, F8_SWU, lane); }
    else cv8_store(v, 64 * (t / 32), ws + WS_WDT, (size_t)e * D + 64 * (t % 32), FFE, F8_SWD, lane);
}
__device__ __forceinline__ void tr_f8_load(const float* W, int N, int k0, int n0, f32x4 (&v)[16], int lane) {
    const int kq = lane >> 4, n4 = (lane & 15) * 4;
#pragma unroll
    for (int i = 0; i < 16; ++i) v[i] = __builtin_nontemporal_load((const GAS f32x4*)(W + (size_t)(k0 + 4 * i + kq) * N + n0 + n4));
}
__device__ __forceinline__ void tr_f8_store(const f32x4 (&v)[16], int k0, unsigned char* WT, size_t drow0, int ldd, float sc, LAS float* scr, int lane) {
    const int kq = lane >> 4, n4 = (lane & 15) * 4;
#pragma unroll
    for (int i = 0; i < 16; ++i) { LAS float* s = scr + (4 * i + kq) * 65 + n4; s[0] = v[i].x; s[1] = v[i].y; s[2] = v[i].z; s[3] = v[i].w; }
    LDS_WAIT(); asm volatile("" ::: "memory");
    const int c = lane & 3;
#pragma unroll
    for (int p = 0; p < 4; ++p) { const int n = (lane >> 2) + 16 * p; const LAS float* s = scr + (16 * c) * 65 + n;
        u32x4 o;
#pragma unroll
        for (int d = 0; d < 4; ++d) o[d] = pk4_fp8(s[(4 * d) * 65] * sc, s[(4 * d + 1) * 65] * sc, s[(4 * d + 2) * 65] * sc, s[(4 * d + 3) * 65] * sc);
        __builtin_nontemporal_store(o, (GAS u32x4*)(WT + (drow0 + n) * ldd + k0 + 16 * c)); }
    LDS_WAIT(); asm volatile("" ::: "memory");
}
__device__ __forceinline__ void tr_tile32(const float* W, int N, int k0, int n0, bf16* WT, size_t drow0, int ldd, LAS float* scr, int lane) {
    float v[16];
#pragma unroll
    for (int i = 0; i < 16; ++i) v[i] = W[(size_t)(k0 + 2 * i + (lane >> 5)) * N + n0 + (lane & 31)];
#pragma unroll
    for (int i = 0; i < 16; ++i) scr[(2 * i + (lane >> 5)) * 33 + (lane & 31)] = v[i];
    LDS_WAIT(); asm volatile("" ::: "memory");
    const int n = lane & 31, hf = lane >> 5; const LAS float* s = scr + (16 * hf) * 33 + n;
    u32x4 o0, o1;
#pragma unroll
    for (int d = 0; d < 4; ++d) { o0[d] = cvt_pk_bf16(s[(2 * d) * 33], s[(2 * d + 1) * 33]); o1[d] = cvt_pk_bf16(s[(8 + 2 * d) * 33], s[(9 + 2 * d) * 33]); }
    GAS u32x4* dst = (GAS u32x4*)(WT + (drow0 + n) * ldd + k0 + 16 * hf); dst[0] = o0; dst[1] = o1;
    LDS_WAIT(); asm volatile("" ::: "memory");
}

__device__ __forceinline__ float row_sumsq(const float* xr, int lane) {
    const GAS f32x4* p = (const GAS f32x4*)xr + lane; float s = 0.f;
#pragma unroll
    for (int j = 0; j < 8; ++j) { const f32x4 v = p[64 * j]; s += (v.x * v.x + v.y * v.y) + (v.z * v.z + v.w * v.w); }
    return wave_sum(s);
}
__device__ __forceinline__ float row_sumsq_b(const bf16* xr, int lane) {
    float s = 0.f;
#pragma unroll
    for (int j = 0; j < 4; ++j) { f32x4 a, c; unpk8(*(const GAS u32x4*)(xr + 8 * lane + 512 * j), a, c); s += ((a.x * a.x + a.y * a.y) + (a.z * a.z + a.w * a.w)) + ((c.x * c.x + c.y * c.y) + (c.z * c.z + c.w * c.w)); }
    return wave_sum(s);
}
__device__ __forceinline__ float rstd_of(float ss) { return 1.0f / sqrtf(ss * (1.0f / D) + RMS_EPS); }

__device__ __forceinline__ void rms_row_bf16(const float* xr, const float* gamma, bf16* orow, int lane) {
    f32x4 v[8]; float s = 0.f;
#pragma unroll
    for (int j = 0; j < 4; ++j) { v[2 * j] = __builtin_nontemporal_load((const GAS f32x4*)(xr + 8 * lane + 512 * j)); v[2 * j + 1] = __builtin_nontemporal_load((const GAS f32x4*)(xr + 8 * lane + 512 * j + 4)); }
#pragma unroll
    for (int j = 0; j < 8; ++j) s += (v[j].x * v[j].x + v[j].y * v[j].y) + (v[j].z * v[j].z + v[j].w * v[j].w);
    const float rs = rstd_of(wave_sum(s));
#pragma unroll
    for (int j = 0; j < 4; ++j) { const f32x4 g0 = *(const GAS f32x4*)(gamma + 8 * lane + 512 * j), g1 = *(const GAS f32x4*)(gamma + 8 * lane + 512 * j + 4);
        const f32x4 a = v[2 * j] * rs * g0, c = v[2 * j + 1] * rs * g1;
        *(GAS u32x4*)(orow + 8 * lane + 512 * j) = (u32x4){cvt_pk_bf16(a.x, a.y), cvt_pk_bf16(a.z, a.w), cvt_pk_bf16(c.x, c.y), cvt_pk_bf16(c.z, c.w)}; }
}

__device__ __forceinline__ void rms_row_bf16_b(const bf16* xr, const float* gamma, bf16* orow, int lane) {
    f32x4 v[8]; float s = 0.f;
#pragma unroll
    for (int j = 0; j < 4; ++j) unpk8(__builtin_nontemporal_load((const GAS u32x4*)(xr + 8 * lane + 512 * j)), v[2 * j], v[2 * j + 1]);
#pragma unroll
    for (int j = 0; j < 8; ++j) s += (v[j].x * v[j].x + v[j].y * v[j].y) + (v[j].z * v[j].z + v[j].w * v[j].w);
    const float rs = rstd_of(wave_sum(s));
#pragma unroll
    for (int j = 0; j < 4; ++j) { const f32x4 g0 = *(const GAS f32x4*)(gamma + 8 * lane + 512 * j), g1 = *(const GAS f32x4*)(gamma + 8 * lane + 512 * j + 4);
        const f32x4 a = v[2 * j] * rs * g0, c = v[2 * j + 1] * rs * g1;
        *(GAS u32x4*)(orow + 8 * lane + 512 * j) = (u32x4){cvt_pk_bf16(a.x, a.y), cvt_pk_bf16(a.z, a.w), cvt_pk_bf16(c.x, c.y), cvt_pk_bf16(c.z, c.w)}; }
}

template <int MODE>
__device__ __forceinline__ void lora_up_item(const bf16* A, int lda, const bf16* Bt, const float* bias, bf16* out, int m0, int n0, int lane, LAS unsigned char* stg) {
    constexpr int KS = 6;
    const int r = lane & 31, hh = lane >> 5;
    bf16x8 af[KS];
#pragma unroll
    for (int s = 0; s < KS; ++s) af[s] = *(const GAS bf16x8*)(A + (size_t)(m0 + r) * lda + 16 * s + 8 * hh);
    bf16x8 bcur[KS]; f32x4 bvc[4];
#pragma unroll
    for (int s = 0; s < KS; ++s) bcur[s] = *(const GAS bf16x8*)(Bt + (size_t)(n0 + r) * (16 * KS) + 16 * s + 8 * hh);
#pragma unroll
    for (int g4 = 0; g4 < 4; ++g4) bvc[g4] = *(const GAS f32x4*)(bias + n0 + 8 * g4 + 4 * hh);
    for (int ct = 0; ct < 16; ++ct) {
        const int nb = n0 + 32 * ct, nn = n0 + 32 * ((ct < 15) ? ct + 1 : ct);
        bf16x8 bnx[KS]; f32x4 bvn[4];
#pragma unroll
        for (int s = 0; s < KS; ++s) bnx[s] = *(const GAS bf16x8*)(Bt + (size_t)(nn + r) * (16 * KS) + 16 * s + 8 * hh);
#pragma unroll
        for (int g4 = 0; g4 < 4; ++g4) bvn[g4] = *(const GAS f32x4*)(bias + nn + 8 * g4 + 4 * hh);
        f32x16 acc;
#pragma unroll
        for (int i = 0; i < 16; ++i) acc[i] = 0.f;
#pragma unroll
        for (int s = 0; s < KS; ++s) acc = __builtin_amdgcn_mfma_f32_32x32x16_bf16(bcur[s], af[s], acc, 0, 0, 0);
#pragma unroll
        for (int g4 = 0; g4 < 4; ++g4) { f32x4 v = (f32x4){acc[4 * g4], acc[4 * g4 + 1], acc[4 * g4 + 2], acc[4 * g4 + 3]} + bvc[g4];
#pragma unroll
            for (int j = 0; j < 4; ++j) v[j] = sigmoidf_(v[j]) * (MODE == 0 ? 0.60653066f : 1.0f);
            *(LAS u32x2*)(stg + r * 144 + ((ct & 1) * 32 + 8 * g4 + 4 * hh) * 2) = (u32x2){cvt_pk_bf16(v[0], v[1]), cvt_pk_bf16(v[2], v[3])}; }
        if (ct & 1) {
            LDS_WAIT(); asm volatile("" ::: "memory");
#pragma unroll
            for (int ps = 0; ps < 4; ++ps) { const int row = (lane >> 3) + 8 * ps, ch = lane & 7;
                const u32x4 w = *(const LAS u32x4*)(stg + row * 144 + ch * 16);
                __builtin_nontemporal_store(w, (GAS u32x4*)(out + (size_t)(m0 + row) * D + nb - 32 + 8 * ch)); }
            LDS_WAIT(); asm volatile("" ::: "memory"); }
#pragma unroll
        for (int s = 0; s < KS; ++s) bcur[s] = bnx[s];
#pragma unroll
        for (int g4 = 0; g4 < 4; ++g4) bvc[g4] = bvn[g4];
    }
}

__device__ __forceinline__ void lora_up_item_k256(const bf16* A, const bf16* Bt, bf16* out, int m0, int n0, int lane, LAS unsigned char* stg) {
    const int r = lane & 31, hh = lane >> 5;
    bf16x8 af[16];
#pragma unroll
    for (int s = 0; s < 16; ++s) af[s] = *(const GAS bf16x8*)(A + (size_t)(m0 + r) * 256 + 16 * s + 8 * hh);
    bf16x8 bcur[8];
#pragma unroll
    for (int s = 0; s < 8; ++s) bcur[s] = *(const GAS bf16x8*)(Bt + (size_t)(n0 + r) * 256 + 16 * s + 8 * hh);
    f32x16 acc;
    for (int hs = 0; hs < 32; ++hs) {
        const int ct = hs >> 1, kh = hs & 1, nb = n0 + 32 * ct;
        const int hn = (hs < 31) ? hs + 1 : hs; const int nn = n0 + 32 * (hn >> 1), kn = hn & 1;
        bf16x8 bnx[8];
#pragma unroll
        for (int s = 0; s < 8; ++s) bnx[s] = *(const GAS bf16x8*)(Bt + (size_t)(nn + r) * 256 + 128 * kn + 16 * s + 8 * hh);
        if (kh == 0) {
#pragma unroll
            for (int i = 0; i < 16; ++i) acc[i] = 0.f;
#pragma unroll
            for (int s = 0; s < 8; ++s) acc = __builtin_amdgcn_mfma_f32_32x32x16_bf16(bcur[s], af[s], acc, 0, 0, 0);
        } else {
#pragma unroll
            for (int s = 0; s < 8; ++s) acc = __builtin_amdgcn_mfma_f32_32x32x16_bf16(bcur[s], af[8 + s], acc, 0, 0, 0);
#pragma unroll
            for (int g4 = 0; g4 < 4; ++g4)
                *(LAS u32x2*)(stg + r * 144 + ((ct & 1) * 32 + 8 * g4 + 4 * hh) * 2) = (u32x2){cvt_pk_bf16(acc[4 * g4], acc[4 * g4 + 1]), cvt_pk_bf16(acc[4 * g4 + 2], acc[4 * g4 + 3])};
            if (ct & 1) {
                LDS_WAIT(); asm volatile("" ::: "memory");
#pragma unroll
                for (int ps = 0; ps < 4; ++ps) { const int row = (lane >> 3) + 8 * ps, ch = lane & 7;
                    const u32x4 w = *(const LAS u32x4*)(stg + row * 144 + ch * 16);
                    __builtin_nontemporal_store(w, (GAS u32x4*)(out + (size_t)(m0 + row) * D + nb - 32 + 8 * ch)); }
                LDS_WAIT(); asm volatile("" ::: "memory"); }
        }
#pragma unroll
        for (int s = 0; s < 8; ++s) bcur[s] = bnx[s];
    }
}

__global__ void __launch_bounds__(512, 2) fwd_kernel(Params p) {
    extern __shared__ __attribute__((aligned(16))) unsigned char lds_raw[];
    LAS unsigned char* lds = (LAS unsigned char*)lds_raw;
    volatile LAS unsigned* MISC = (volatile LAS unsigned*)(lds + MISC_OFF);
    const int tid = threadIdx.x, lane = tid & 63, wave = __builtin_amdgcn_readfirstlane(tid >> 6);
    const int G = gridDim.x, bid = blockIdx.x;
    const int gw = bid * 8 + wave, NGW = G * 8;
    unsigned char* ws = p.ws;
    if (tid < 64) MISC[tid] = 0u;
    __syncthreads();
    const XcdBarrier bar = xcd_barrier_post((unsigned*)(ws + WS_CTL) + 4096, MISC);
    const int lo = p.ph_lo, hi = p.ph_hi;
#define IN(k) (lo <= (k) && (k) < hi)
#define SEAM(k) do { if (IN(k) && IN((k) + 1)) xcd_barrier(bar); } while (0)

    const float* x = p.in[0];
    bf16* Hh = (bf16*)(ws + WS_H);

    if (IN(0)) for (int rep_ = 0; rep_ < REP0; ++rep_) {
        LAS float* scr = (LAS float*)lds + wave * (64 * 65);
        constexpr int T_POOL = 4 * 64, T_FFN = 32 * 88, T_SQ = 32 * 32, T_G1 = 32 * 4;
        constexpr int NT0 = T_POOL + 3 * T_FFN + 4 * T_SQ + T_G1;
        for (int it = gw; it < NT0; it += NGW) {
            int r = it; const float* W; int N, kb, nb; bf16* WT; size_t drow; int ldd; const float* ksc = nullptr;
            if (r < T_POOL) { const int g = r >> 6, t = r & 63; W = p.in[2] + (size_t)g * 512 * 512; N = 512; kb = t >> 3; nb = t & 7; WT = (bf16*)(ws + WS_POOLT); drow = (size_t)g * 512 + 64 * nb; ldd = 512; }
            else if ((r -= T_POOL) < T_FFN) { W = p.in[5]; N = FF0; kb = r / 88; nb = r % 88; WT = (bf16*)(ws + WS_FFN1T); drow = (size_t)((64 * nb) >> 7) * 256 + ((64 * nb) & 127); ldd = D; ksc = p.in[4]; }
            else if ((r -= T_FFN) < T_FFN) { W = p.in[6]; N = FF0; kb = r / 88; nb = r % 88; WT = (bf16*)(ws + WS_FFN1T); drow = (size_t)((64 * nb) >> 7) * 256 + 128 + ((64 * nb) & 127); ldd = D; ksc = p.in[4]; }
            else if ((r -= T_FFN) < T_FFN) {
                if constexpr (FFN_DOWN_FP8) { f32x4 v8[16]; cv8_load(p.in[7], D, 64 * (r / 32), 64 * (r % 32), v8, lane); cv8_store(v8, 64 * (r / 32), ws + WS_FFN2T, (size_t)64 * (r % 32), FF0, F8_SWD0, lane); continue; }
                else { W = p.in[7]; N = D; kb = r / 32; nb = r % 32; WT = (bf16*)(ws + WS_FFN2T); drow = 64 * nb; ldd = FF0; } }
            else if ((r -= T_FFN) < 3 * T_SQ) { const int w = r / T_SQ, t = r % T_SQ; W = p.in[10 + w]; N = D; kb = t / 32; nb = t % 32; WT = (bf16*)(ws + WS_RKVLOT); drow = (size_t)w * D + 64 * nb; ldd = D; }
            else if ((r -= 3 * T_SQ) < T_SQ) { W = p.in[13]; N = D; kb = r / 32; nb = r % 32; WT = (bf16*)(ws + WS_WOT); drow = 64 * nb; ldd = D; }
            else { r -= T_SQ; W = p.in[20]; N = LOG; kb = r / 4; nb = r % 4; WT = (bf16*)(ws + WS_RKVLOT); drow = (size_t)6656 + 64 * nb; ldd = D; }
            tr_tile(W, N, 64 * kb, 64 * nb, WT, drow, ldd, scr, lane, ksc);
        }
        {
            LAS float* scr32 = (LAS float*)lds + wave * (64 * 65);
            bf16* RK = (bf16*)(ws + WS_RKVLOT);
            for (int it = gw; it < 2048; it += NGW) {
                if (it < 768) { const int q = it / 384, r = it % 384, e = r / 192, t = r % 192, kb = t / 3, nb = t % 3;
                    tr_tile32(p.in[q ? 18 : 15] + (size_t)e * D * LOR, LOR, 32 * kb, 32 * nb, RK, (size_t)(q ? 6400 : 6144) + 96 * e + 32 * nb, D, scr32, lane); }
                else if (it < 1536) { const int r0_ = it - 768, q = r0_ / 384, r = r0_ % 384, e = r / 192, t = r % 192, kb = t / 64, nb = t % 64;
                    tr_tile32(p.in[q ? 19 : 16] + (size_t)e * LOR * D, D, 32 * kb, 32 * nb, (bf16*)(ws + (q ? WS_AW2T : WS_DW2T)), (size_t)e * D + 32 * nb, LOR, scr32, lane); }
                else { const int t = it - 1536, kb = t / 64, nb = t % 64;
                    tr_tile32(p.in[21], D, 32 * kb, 32 * nb, (bf16*)(ws + WS_G2T), (size_t)32 * nb, LOG, scr32, lane); }
            }
            const int gt = bid * 512 + tid, GT = G * 512;
            for (int i = gt; i < 64 * D; i += GT) { RK[(size_t)(6144 + 192) * D + i] = 0; RK[(size_t)(6400 + 192) * D + i] = 0; }
        }
        __syncthreads();
        LAS float* rs = (LAS float*)lds;
        bf16* PO = (bf16*)(ws + WS_POOLED);
        for (int chunk = bid; chunk < NCHUNK; chunk += G) {
            const int r0 = chunk * 64, blo = (r0 / SEQ) * SEQ, bhi = blo + SEQ;
            for (int i = 0; i < 10; ++i) { const int rr = r0 - 8 + wave * 10 + i; if (rr >= blo && rr < bhi) { const float ss = row_sumsq(x + (size_t)rr * D, lane); if (lane == 0) rs[wave * 10 + i] = rstd_of(ss); } }
            __syncthreads();
            const int hf = tid >> 8, c = 8 * (tid & 255), Wh = 1 << ((tid & 255) >> 6);
            const f32x4 gam0 = *(const GAS f32x4*)(p.in[1] + c), gam1 = *(const GAS f32x4*)(p.in[1] + c + 4);
            const int rbeg = r0 + 32 * hf;
            f32x4 s0 = (f32x4){0.f, 0.f, 0.f, 0.f}, s1 = s0;
            for (int rr = max(rbeg - Wh, blo); rr < min(rbeg + Wh, bhi); ++rr) { const float sc = rs[rr - (r0 - 8)]; s0 = s0 + *(const GAS f32x4*)(x + (size_t)rr * D + c) * sc; s1 = s1 + *(const GAS f32x4*)(x + (size_t)rr * D + c + 4) * sc; }
            for (int t = 0; t < 32; ++t) { const int row = rbeg + t; const int s_lo = max(row - Wh, blo), s_hi = min(row + Wh, bhi);
                const float sc = rs[row - (r0 - 8)], inv = 1.0f / (float)(s_hi - s_lo);
                const f32x4 c0 = *(const GAS f32x4*)(x + (size_t)row * D + c) * sc, c1 = *(const GAS f32x4*)(x + (size_t)row * D + c + 4) * sc;
                const f32x4 o0 = (s0 * inv - c0) * gam0, o1 = (s1 * inv - c1) * gam1;
                *(GAS u32x4*)(PO + (size_t)row * D + c) = (u32x4){cvt_pk_bf16(o0.x, o0.y), cvt_pk_bf16(o0.z, o0.w), cvt_pk_bf16(o1.x, o1.y), cvt_pk_bf16(o1.z, o1.w)};
                const int ent = row + Wh, lev = row - Wh;
                if (ent < bhi) { const float se = rs[ent - (r0 - 8)]; s0 = s0 + *(const GAS f32x4*)(x + (size_t)ent * D + c) * se; s1 = s1 + *(const GAS f32x4*)(x + (size_t)ent * D + c + 4) * se; }
                if (lev >= blo) { const float sl = rs[lev - (r0 - 8)]; s0 = s0 - *(const GAS f32x4*)(x + (size_t)lev * D + c) * sl; s1 = s1 - *(const GAS f32x4*)(x + (size_t)lev * D + c + 4) * sl; } }
            __syncthreads();
        }
    }
    SEAM(0);

    if (IN(1)) {
        pg8::Gemm g{(const bf16*)(ws + WS_POOLED), (const bf16*)(ws + WS_POOLT), D, 512, 512};
        SchedPool S; S.T.init(M / 256, 8, G, bid);
        pg8::EpiPool E{x, Hh, p.in[3], (LAS float*)(lds + 131072), (float*)(ws + WS_PART)};
        pg8::gemm_phase<pg8::EpiPool, SchedPool, true, true>(lds, g, S, E);
    }
    SEAM(1);


    if (IN(3)) for (int rep_ = 0; rep_ < REP3; ++rep_) {
        pg8::Gemm g{(const bf16*)Hh, (const bf16*)(ws + WS_FFN1T), D, D, D};
        SchedPlain S; S.T.init(M / 256, 2 * FF0 / 256, G, bid); S.astep = (unsigned long long)256 * D * 2; S.bstep = (unsigned long long)256 * D * 2;
        if constexpr (FFN_DOWN_FP8) { pg8::EpiSwigluF8R E{ws + WS_ACT0, FF0, F8_SH0, (const float*)(ws + WS_PART)}; pg8::gemm_phase(lds, g, S, E); }
        else { pg8::EpiSwiglu E{(bf16*)(ws + WS_ACT0), FF0, (const float*)(ws + WS_PART)}; pg8::gemm_phase(lds, g, S, E); }
    }
    SEAM(3);

    if (IN(4)) {
        constexpr int KU = FFN_DOWN_FP8 ? FF0 / 2 : FF0;
        pg8::Gemm g{(const bf16*)(ws + WS_ACT0), (const bf16*)(ws + WS_FFN2T), KU, KU, KU};
        SchedPlain S; S.T.init(M / 256, D / 256, G, bid); S.astep = (unsigned long long)256 * KU * 2; S.bstep = (unsigned long long)256 * KU * 2;
        pg8::EpiResid E{Hh, FFN_DOWN_FP8 ? 1.0f / (F8_SH0 * F8_SWD0) : 1.0f};
        pg8::gemm_phase<pg8::EpiResid, SchedPlain, false, true, FFN_DOWN_FP8>(lds, g, S, E);
    }
    SEAM(4);

    if (IN(5)) for (int rep_ = 0; rep_ < REP5; ++rep_) {
        LAS float* rs = (LAS float*)lds;
        bf16* MX = (bf16*)(ws + WS_MIX);
        const int hf = tid >> 8, c = 8 * (tid & 255);
        const f32x4 gam0 = *(const GAS f32x4*)(p.in[8] + c), gam1 = *(const GAS f32x4*)(p.in[8] + c + 4);
        f32x4 mc0[6], mc1[6];
#pragma unroll
        for (int i = 0; i < 6; ++i) { mc0[i] = *(const GAS f32x4*)(p.in[9] + (size_t)i * D + c); mc1[i] = *(const GAS f32x4*)(p.in[9] + (size_t)i * D + c + 4); }
        for (int chunk = bid; chunk < NCHUNK; chunk += G) {
            const int r0 = chunk * 64, blo = (r0 / SEQ) * SEQ, bhi = blo + SEQ;
            {
#pragma unroll
                for (int i3 = 0; i3 < 3; ++i3) { u32x4 w[3][4]; bool ok[3];
#pragma unroll
                    for (int q3 = 0; q3 < 3; ++q3) { const int li = wave * 9 + 3 * i3 + q3; const int rr = r0 - 1 + li; ok[q3] = (li < 66 && rr >= blo && rr < bhi); const int rc = ok[q3] ? rr : r0;
#pragma unroll
                        for (int j = 0; j < 4; ++j) w[q3][j] = *(const GAS u32x4*)(Hh + (size_t)rc * D + 8 * lane + 512 * j); }
#pragma unroll
                    for (int q3 = 0; q3 < 3; ++q3) { float ss = 0.f;
#pragma unroll
                        for (int j = 0; j < 4; ++j) { f32x4 a4, c4; unpk8(w[q3][j], a4, c4); ss += ((a4.x * a4.x + a4.y * a4.y) + (a4.z * a4.z + a4.w * a4.w)) + ((c4.x * c4.x + c4.y * c4.y) + (c4.z * c4.z + c4.w * c4.w)); }
                        ss = wave_sum(ss); if (ok[q3] && lane == 0) rs[wave * 9 + 3 * i3 + q3] = rstd_of(ss); } } }
            __syncthreads();
            const f32x4 z4 = (f32x4){0.f, 0.f, 0.f, 0.f};
            const int rbeg = r0 + 32 * hf;
            auto ldrow = [&](int row, u32x4& w) { const int rc = (row >= blo && row < bhi) ? row : r0; w = *(const GAS u32x4*)(Hh + (size_t)rc * D + c); };
            auto cvrow = [&](int row, const u32x4& w, f32x4& o0, f32x4& o1) { if (row >= blo && row < bhi) { const float sc = rs[row - (r0 - 1)]; unpk8(w, o0, o1); o0 = o0 * sc * gam0; o1 = o1 * sc * gam1; } else { o0 = z4; o1 = z4; } };
            u32x4 wp, wc, wa, wb; ldrow(rbeg - 1, wp); ldrow(rbeg, wc); ldrow(rbeg + 1, wa);
            f32x4 p0, p1, c0, c1; cvrow(rbeg - 1, wp, p0, p1); cvrow(rbeg, wc, c0, c1);
            auto step = [&](int row, const u32x4& wnext) {
                f32x4 n0, n1; cvrow(row + 1, wnext, n0, n1);
                const f32x4 x0 = (p0 + n0) * 0.5f - c0, x1 = (p1 + n1) * 0.5f - c1;
#pragma unroll
                for (int i = 0; i < 6; ++i) { const f32x4 o0 = c0 + x0 * mc0[i], o1 = c1 + x1 * mc1[i];
                    __builtin_nontemporal_store(((u32x4){cvt_pk_bf16(o0.x, o0.y), cvt_pk_bf16(o0.z, o0.w), cvt_pk_bf16(o1.x, o1.y), cvt_pk_bf16(o1.z, o1.w)}), (GAS u32x4*)(MX + ((size_t)i * M + row) * D + c)); }
                p0 = c0; p1 = c1; c0 = n0; c1 = n1; };
            for (int t = 0; t < 32; t += 2) { const int row = rbeg + t;
                ldrow(row + 2, wb); step(row, wa);
                ldrow(row + 3, wa); step(row + 1, wb); }
            __syncthreads();
        }
    }
    SEAM(5);

    if (IN(6)) for (int rep_ = 0; rep_ < REP6; ++rep_) {
        pg8::Gemm g{(const bf16*)(ws + WS_MIX), (const bf16*)(ws + WS_RKVLOT), D, D, D};
        SchedRkvLo S; S.T.init(M / 256, 27, G, bid);
        pg8::EpiRkvLo E{(bf16*)(ws + WS_RKV), (bf16*)(ws + WS_LO)};
        pg8::gemm_phase(lds, g, S, E);
    }
    SEAM(6);

    if (IN(7)) for (int rep_ = 0; rep_ < REP7; ++rep_) {
        const bf16* LO_ = (const bf16*)(ws + WS_LO);
        for (int it = gw; it < 512 * 5 * 4; it += NGW) {
            const int cq = it & 3, tq = (it >> 2) % 5, rt = (it >> 2) / 5; const int m0 = rt * 32, n0 = cq * 512;
            if (tq < 2) lora_up_item<0>(LO_ + 96 * tq, 256, (const bf16*)(ws + WS_DW2T) + (size_t)tq * D * LOR, p.in[14] + (size_t)tq * D, (bf16*)(ws + WS_EW) + (size_t)tq * M * D, m0, n0, lane, lds + wave * 4608);
            else if (tq < 4) lora_up_item<1>(LO_ + (size_t)M * 256 + 96 * (tq - 2), 256, (const bf16*)(ws + WS_AW2T) + (size_t)(tq - 2) * D * LOR, p.in[17] + (size_t)(tq - 2) * D, (bf16*)(ws + WS_AA) + (size_t)(tq - 2) * M * D, m0, n0, lane, lds + wave * 4608);
            else lora_up_item_k256(LO_ + (size_t)2 * M * 256, (const bf16*)(ws + WS_G2T), (bf16*)(ws + WS_GG), m0, n0, lane, lds + wave * 4608);
        }
    }
    SEAM(7);

    if (IN(8)) for (int rep_ = 0; rep_ < REP8; ++rep_) {
        constexpr int PT = 144;
        constexpr int OFF_AT = 0, OFF_RT = 9216, OFF_BM = 18432, OFF_KM = 27648, OFF_BMT = 36864, OFF_KMT = 46080, OFF_VT = 55296;
        constexpr int OFF_LAB = 64512, OFF_LAK = 73728, OFF_MRB = 82944, OFF_MRK = 92160, OFF_TBB = 101376, OFF_LD = 103424, OFF_GC = 107520, OFF_WTOT = 107776, OFF_YB = 109824;
        const int q = lane >> 4, c16 = lane & 15;
        const bf16* RKV = (const bf16*)(ws + WS_RKV);
#define WK_NAT(off, row, kb) (*(const LAS bf16x8*)(lds + (off) + (row) * PT + ((kb) + 8 * q) * 2))
#define WK_MFMA(a, b, c) __builtin_amdgcn_mfma_f32_16x16x32_bf16((a), (b), (c), 0, 0, 0)
        auto ld_rho = [&](int off, int row, int kb) -> bf16x8 {
            const u32x2 lo2 = *(const LAS u32x2*)(lds + off + row * PT + (kb + 4 * q) * 2), hi2 = *(const LAS u32x2*)(lds + off + row * PT + (kb + 16 + 4 * q) * 2);
            const u32x4 w4 = (u32x4){lo2.x, lo2.y, hi2.x, hi2.y}; return __builtin_bit_cast(bf16x8, w4); };
        auto packB = [&](const f32x4& a, const f32x4& b) -> bf16x8 {
            const u32x4 w4 = (u32x4){cvt_pk_bf16(a[0], a[1]), cvt_pk_bf16(a[2], a[3]), cvt_pk_bf16(b[0], b[1]), cvt_pk_bf16(b[2], b[3])}; return __builtin_bit_cast(bf16x8, w4); };
        for (int i = tid; i < (OFF_LD - OFF_LAB) / 16; i += 512) *(LAS u32x4*)(lds + OFF_LAB + i * 16) = (u32x4){0u, 0u, 0u, 0u};
        __syncthreads();
        if (bid < 2 * BATCH * NH) { const int u = bid;
            const int dir = u / (BATCH * NH), b = (u % (BATCH * NH)) / NH, h = u % NH;
            const bool fwd = (dir == 0);
            const size_t rowbase = (size_t)b * SEQ; const int col = h * HS + lane;
            const bf16* EW = (const bf16*)(ws + WS_EW) + (size_t)dir * M * D; const bf16* AA = (const bf16*)(ws + WS_AA) + (size_t)dir * M * D;
            bf16* Yo = (bf16*)(ws + WS_Y) + (size_t)dir * M * D;
            const float kkc = p.in[22][col], kac = p.in[23][col], rkc = p.in[24][col];
            float* BSo = (float*)(ws + WS_BS) + (size_t)dir * M * NH;
            constexpr int OFF_PM = 126464;
            static_assert(OFF_PM + 64 * PT <= MISC_OFF, "Pm");
            f32x4 ST[4];
#pragma unroll
            for (int i = 0; i < 4; ++i) ST[i] = (f32x4){0.f, 0.f, 0.f, 0.f};
            constexpr int OFF_RAW = OFF_LAB;
            auto ldraw = [&](int cc, u32x4 (&pf)[5]) { cc = (cc < SEQ / 64) ? cc : SEQ / 64 - 1;
                const int tl = cc * 64 + 8 * wave + (lane >> 3); const int t = fwd ? tl : SEQ - 1 - tl; const size_t o = (rowbase + t) * D + h * HS + 8 * (lane & 7);
                pf[0] = __builtin_nontemporal_load((const GAS u32x4*)(RKV + o)); pf[1] = __builtin_nontemporal_load((const GAS u32x4*)(RKV + (size_t)M * D + o)); pf[2] = __builtin_nontemporal_load((const GAS u32x4*)(RKV + (size_t)2 * M * D + o));
                pf[3] = __builtin_nontemporal_load((const GAS u32x4*)(EW + o)); pf[4] = __builtin_nontemporal_load((const GAS u32x4*)(AA + o)); };
            u32x4 pfA[5], pfB[5];
            ldraw(0, pfA); ldraw(1, pfB);
            auto chunk_body = [&](const int c, u32x4 (&pf)[5]) __attribute__((always_inline)) {
                {
                    const int cp = (c > 0) ? c - 1 : 0;
#pragma unroll
                    for (int j = 0; j < 8; ++j) { const int tl = cp * 64 + 8 * wave + j; const int t = fwd ? tl : SEQ - 1 - tl;
                        Yo[(rowbase + t) * D + col] = (bf16)cvt_pk_bf16(((const LAS float*)(lds + OFF_YB))[(8 * wave + j) * 65 + lane], 0.f); } }
#pragma unroll
                for (int x5 = 0; x5 < 5; ++x5) *(LAS u32x4*)(lds + OFF_RAW + x5 * 8192 + (8 * wave + (lane >> 3)) * 128 + (lane & 7) * 16) = pf[x5];
                ldraw(c + 2, pf);
                f32x4 cvb[16]; const int cvit = (c * NCW + (wave - CVW0)) * 256 + bid;
                LDS_WAIT(); __builtin_amdgcn_s_barrier(); asm volatile("" ::: "memory");
                unsigned short rr_[8], rk_[8], rv_[8], re_[8], ra_[8];
#pragma unroll
                for (int j = 0; j < 8; ++j) { const LAS unsigned short* rp = (const LAS unsigned short*)(lds + OFF_RAW + (8 * wave + j) * 128 + lane * 2);
                    rr_[j] = rp[0]; rk_[j] = rp[4096]; rv_[j] = rp[8192]; re_[j] = rp[12288]; ra_[j] = rp[16384]; }
                float lgl[8]; { float cs = 0.f;
#pragma unroll
                    for (int j = 0; j < 8; ++j) { cs -= bf2f(re_[j]); lgl[j] = cs; } }
                ((LAS float*)(lds + OFF_WTOT))[wave * 64 + lane] = lgl[7];
                LDS_WAIT(); __builtin_amdgcn_s_barrier(); asm volatile("" ::: "memory");
                float off = 0.f;
                { float wt[8];
#pragma unroll
                  for (int w2 = 0; w2 < 8; ++w2) wt[w2] = ((const LAS float*)(lds + OFF_WTOT))[w2 * 64 + lane];
#pragma unroll
                  for (int w2 = 0; w2 < 7; ++w2) off += (w2 < wave) ? wt[w2] : 0.f; }
                {
                    unsigned bt[8], kt[8];
                    float rig_prev = __expf(off);
#pragma unroll
                    for (int j = 0; j < 8; ++j) { const int t = 8 * wave + j;
                        const float lg = off + lgl[j];
                        const float rf = bf2f(rr_[j]), kf = bf2f(rk_[j]), af = bf2f(ra_[j]);
                        const float kkr = kf * kkc; const float n2 = wave_sum(kkr * kkr); const float kkn = kkr * __builtin_amdgcn_rsqf(fmaxf(n2, 1e-24f));
                        const float ig = __expf(-lg), gt = __builtin_amdgcn_rcpf(ig), eg = rig_prev;
                        rig_prev = gt;
                        const unsigned ar_ = cvt_pk_bf16(-kkn * eg, rf * (fwd ? gt : eg));
                        const float kmod = kf * (1.0f + (af - 1.0f) * kac);
                        const unsigned bk_ = cvt_pk_bf16(kkn * af * ig, kmod * ig);
                        *(LAS unsigned short*)(lds + OFF_PM + t * PT + lane * 2) = (unsigned short)cvt_pk_bf16(rf * kmod * rkc, 0.f);
                        *(LAS unsigned short*)(lds + OFF_AT + t * PT + lane * 2) = (unsigned short)ar_;
                        *(LAS unsigned short*)(lds + OFF_RT + t * PT + lane * 2) = (unsigned short)(ar_ >> 16);
                        *(LAS unsigned short*)(lds + OFF_BM + t * PT + lane * 2) = (unsigned short)bk_;
                        *(LAS unsigned short*)(lds + OFF_KM + t * PT + lane * 2) = (unsigned short)(bk_ >> 16);
                        bt[j] = bk_ & 0xffffu; kt[j] = bk_ >> 16; }
                    *(LAS u32x4*)(lds + OFF_BMT + lane * PT + wave * 16) = (u32x4){bt[0] | (bt[1] << 16), bt[2] | (bt[3] << 16), bt[4] | (bt[5] << 16), bt[6] | (bt[7] << 16)};
                    *(LAS u32x4*)(lds + OFF_KMT + lane * PT + wave * 16) = (u32x4){kt[0] | (kt[1] << 16), kt[2] | (kt[3] << 16), kt[4] | (kt[5] << 16), kt[6] | (kt[7] << 16)};
                    *(LAS u32x4*)(lds + OFF_VT + lane * PT + wave * 16) = (u32x4){(unsigned)rv_[0] | ((unsigned)rv_[1] << 16), (unsigned)rv_[2] | ((unsigned)rv_[3] << 16), (unsigned)rv_[4] | ((unsigned)rv_[5] << 16), (unsigned)rv_[6] | ((unsigned)rv_[7] << 16)};
                    {
                        const int mtx = tid >> 7, tl2 = (tid >> 6) & 1, r16 = (tid >> 2) & 15;
                        const int offM = (mtx == 0) ? OFF_LAK : (mtx == 1) ? OFF_MRB : (mtx == 2) ? OFF_MRK : OFF_LAB;
                        *(LAS u32x2*)(lds + offM + (32 * tl2 + r16) * PT + (32 * tl2 + 16) * 2 + (tid & 3) * 8) = (u32x2){0u, 0u}; }
                    if (wave == 7) ((LAS float*)(lds + OFF_GC))[lane] = __expf(off + lgl[7]);
                }
                LDS_WAIT(); __builtin_amdgcn_s_barrier(); asm volatile("" ::: "memory");
                auto s1_tile = [&](int pr, int tt, int it) {
                    const int offX = (pr & 1) ? OFF_KM : OFF_BM, offY = (pr & 2) ? OFF_RT : OFF_AT;
                    const int offD = (pr == 0) ? OFF_LAB : (pr == 1) ? OFF_LAK : (pr == 2) ? OFF_MRB : OFF_MRK;
                    const bf16x8 x0 = WK_NAT(offX, 16 * it + c16, 0), x1 = WK_NAT(offX, 16 * it + c16, 32), y0 = WK_NAT(offY, 16 * tt + c16, 0), y1 = WK_NAT(offY, 16 * tt + c16, 32);
                    f32x4 acc = (f32x4){0.f, 0.f, 0.f, 0.f};
                    acc = WK_MFMA(x0, y0, acc); acc = WK_MFMA(x1, y1, acc);
                    const int t = 16 * tt + c16, i0 = 16 * it + 4 * q; const bool incl = (pr >= 2) && fwd;
#pragma unroll
                    for (int r4 = 0; r4 < 4; ++r4) { const int i = i0 + r4; const bool keep = incl ? (i <= t) : (i < t); acc[r4] = keep ? acc[r4] : 0.f; }
                    *(LAS u32x2*)(lds + offD + t * PT + i0 * 2) = (u32x2){cvt_pk_bf16(acc[0], acc[1]), cvt_pk_bf16(acc[2], acc[3])};
                    if (pr == 0 && tt == it) {
#pragma unroll
                        for (int r4 = 0; r4 < 4; ++r4) *(LAS float*)(lds + OFF_LD + tt * 1024 + (4 * q + r4) * 64 + c16 * 4) = acc[r4]; } };
                auto tile_of = [&](int ti, int& tt, int& it) { tt = (ti >= 6) ? 3 : (ti >= 3) ? 2 : (ti >= 1) ? 1 : 0; it = ti - (tt * (tt + 1)) / 2; };
                for (int n3 = 0; n3 < 3; ++n3) { const int a = wave * 3 + n3; int pr, tt, it;
                    if (a < 4) { pr = 0; tt = a; it = a; } else if (a < 14) { pr = 1; tile_of(a - 4, tt, it); } else { pr = 3; tile_of(a - 14, tt, it); }
                    s1_tile(pr, tt, it); }
                if (wave >= 4) {
                    const int blk = wave - 4; const bf16x8 ones = __builtin_bit_cast(bf16x8, ((u32x4){0x3F803F80u, 0x3F803F80u, 0x3F803F80u, 0x3F803F80u}));
                    f32x4 bsum = WK_MFMA(WK_NAT(OFF_PM, 16 * blk + c16, 0), ones, ((f32x4){0.f, 0.f, 0.f, 0.f})); bsum = WK_MFMA(WK_NAT(OFF_PM, 16 * blk + c16, 32), ones, bsum);
                    if (c16 == 0) {
#pragma unroll
                        for (int r4 = 0; r4 < 4; ++r4) { const int tlb = c * 64 + 16 * blk + 4 * q + r4; const int tb = fwd ? tlb : SEQ - 1 - tlb; BSo[(rowbase + tb) * NH + h] = bsum[r4]; } } }
                LDS_WAIT(); __builtin_amdgcn_s_barrier(); asm volatile("" ::: "memory");
                const f32x4 z4 = (f32x4){0.f, 0.f, 0.f, 0.f};
                bf16x8 Sb[2], Vb[2]; f32x4 accA[4], yv[4], sacc[4];
                if (wave == 4) {
                    if (CVW0 <= 4) moe_cv_load(p.in, cvit, cvb, lane);
                    {
                    float Tr[16];
                    const LAS float* Lq = (const LAS float*)(lds + OFF_LD + q * 1024);
#pragma unroll
                    for (int r = 0; r < 16; ++r) Tr[r] = (r == c16) ? 1.0f : 0.0f;
#pragma unroll
                    for (int i = 0; i < 15; ++i) {
#pragma unroll
                        for (int k4 = (i + 1) / 4; k4 < 4; ++k4) { const f32x4 lv = *(const LAS f32x4*)(Lq + i * 16 + 4 * k4);
#pragma unroll
                            for (int e = 0; e < 4; ++e) if (4 * k4 + e > i) Tr[4 * k4 + e] += lv[e] * Tr[i]; } }
#pragma unroll
                    for (int r = 0; r < 16; ++r) *(LAS unsigned short*)(lds + OFF_TBB + q * 512 + r * 32 + c16 * 2) = (unsigned short)cvt_pk_bf16(Tr[r], 0.f);
                    }
                    LDS_WAIT(); __builtin_amdgcn_s_barrier(); asm volatile("" ::: "memory");
                    if (CVW0 <= 4) moe_cv_store(ws, cvit, cvb, lane);
                } else if (wave > 4) {
                    if (wave >= CVW0) moe_cv_load(p.in, cvit, cvb, lane);
                    f32x2 cvh[16]; const int hidx = (c * 3 + (wave - 5)) * 256 + bid; const bool hon = hidx < MOE_CV_HALVES;
                    if (hon) moe_cvh_load(p.in, MOE_CV_EARLY + (hidx >> 1), hidx & 1, cvh, lane);
                    for (int bb = wave - 5; bb < 16; bb += 3) { int pr, tt, it;
                        if (bb < 6) { pr = 0; const int ti = (bb == 0) ? 1 : (bb == 1) ? 3 : (bb == 2) ? 4 : (bb == 3) ? 6 : (bb == 4) ? 7 : 8; tile_of(ti, tt, it); } else { pr = 2; tile_of(bb - 6, tt, it); }
                        s1_tile(pr, tt, it); }
                    LDS_WAIT(); __builtin_amdgcn_s_barrier(); asm volatile("" ::: "memory");
                    if (wave >= CVW0) moe_cv_store(ws, cvit, cvb, lane);
                    if (hon) moe_cvh_store(ws, MOE_CV_EARLY + (hidx >> 1), hidx & 1, cvh, lane);
                } else {
                    Sb[0] = packB(ST[0], ST[1]); Sb[1] = packB(ST[2], ST[3]);
                    Vb[0] = WK_NAT(OFF_VT, 16 * wave + c16, 0); Vb[1] = WK_NAT(OFF_VT, 16 * wave + c16, 32);
                    {
                        bf16x8 fLak[6], fAt[8];
                        fLak[0] = WK_NAT(OFF_LAK, c16, 0); fLak[1] = WK_NAT(OFF_LAK, 16 + c16, 0); fLak[2] = WK_NAT(OFF_LAK, 32 + c16, 0); fLak[3] = WK_NAT(OFF_LAK, 32 + c16, 32); fLak[4] = WK_NAT(OFF_LAK, 48 + c16, 0); fLak[5] = WK_NAT(OFF_LAK, 48 + c16, 32);
#pragma unroll
                        for (int blk = 0; blk < 4; ++blk) { fAt[2 * blk] = ld_rho(OFF_AT, 16 * blk + c16, 0); fAt[2 * blk + 1] = ld_rho(OFF_AT, 16 * blk + c16, 32); }
                        __builtin_amdgcn_sched_barrier(0);
                        accA[0] = WK_MFMA(fLak[0], Vb[0], z4); accA[0] = WK_MFMA(fAt[0], Sb[0], accA[0]); accA[0] = WK_MFMA(fAt[1], Sb[1], accA[0]);
                        accA[1] = WK_MFMA(fLak[1], Vb[0], z4); accA[1] = WK_MFMA(fAt[2], Sb[0], accA[1]); accA[1] = WK_MFMA(fAt[3], Sb[1], accA[1]);
                        accA[2] = WK_MFMA(fLak[2], Vb[0], z4); accA[2] = WK_MFMA(fLak[3], Vb[1], accA[2]); accA[2] = WK_MFMA(fAt[4], Sb[0], accA[2]); accA[2] = WK_MFMA(fAt[5], Sb[1], accA[2]);
                        accA[3] = WK_MFMA(fLak[4], Vb[0], z4); accA[3] = WK_MFMA(fLak[5], Vb[1], accA[3]); accA[3] = WK_MFMA(fAt[6], Sb[0], accA[3]); accA[3] = WK_MFMA(fAt[7], Sb[1], accA[3]);
                    }
                    __builtin_amdgcn_sched_barrier(0);
                    {
                        bf16x8 fRt[8], fMrk[6];
#pragma unroll
                        for (int blk = 0; blk < 4; ++blk) { fRt[2 * blk] = ld_rho(OFF_RT, 16 * blk + c16, 0); fRt[2 * blk + 1] = ld_rho(OFF_RT, 16 * blk + c16, 32); }
                        fMrk[0] = WK_NAT(OFF_MRK, c16, 0); fMrk[1] = WK_NAT(OFF_MRK, 16 + c16, 0); fMrk[2] = WK_NAT(OFF_MRK, 32 + c16, 0); fMrk[3] = WK_NAT(OFF_MRK, 32 + c16, 32); fMrk[4] = WK_NAT(OFF_MRK, 48 + c16, 0); fMrk[5] = WK_NAT(OFF_MRK, 48 + c16, 32);
                        __builtin_amdgcn_sched_barrier(0);
                        yv[0] = WK_MFMA(fRt[0], Sb[0], z4); yv[0] = WK_MFMA(fRt[1], Sb[1], yv[0]); yv[0] = WK_MFMA(fMrk[0], Vb[0], yv[0]);
                        yv[1] = WK_MFMA(fRt[2], Sb[0], z4); yv[1] = WK_MFMA(fRt[3], Sb[1], yv[1]); yv[1] = WK_MFMA(fMrk[1], Vb[0], yv[1]);
                        yv[2] = WK_MFMA(fRt[4], Sb[0], z4); yv[2] = WK_MFMA(fRt[5], Sb[1], yv[2]); yv[2] = WK_MFMA(fMrk[2], Vb[0], yv[2]); yv[2] = WK_MFMA(fMrk[3], Vb[1], yv[2]);
                        yv[3] = WK_MFMA(fRt[6], Sb[0], z4); yv[3] = WK_MFMA(fRt[7], Sb[1], yv[3]); yv[3] = WK_MFMA(fMrk[4], Vb[0], yv[3]); yv[3] = WK_MFMA(fMrk[5], Vb[1], yv[3]);
                    }
                    __builtin_amdgcn_sched_barrier(0);
                    {
                        bf16x8 fK[8];
#pragma unroll
                        for (int kt = 0; kt < 4; ++kt) { fK[2 * kt] = WK_NAT(OFF_KMT, 16 * kt + c16, 0); fK[2 * kt + 1] = WK_NAT(OFF_KMT, 16 * kt + c16, 32); }
                        __builtin_amdgcn_sched_barrier(0);
#pragma unroll
                        for (int kt = 0; kt < 4; ++kt) { sacc[kt] = WK_MFMA(fK[2 * kt], Vb[0], ST[kt]); sacc[kt] = WK_MFMA(fK[2 * kt + 1], Vb[1], sacc[kt]); }
                    }
                    LDS_WAIT(); __builtin_amdgcn_s_barrier(); asm volatile("" ::: "memory");
                    bf16x8 fLab[4]; u32x2 fT[4];
                    fLab[0] = ld_rho(OFF_LAB, 16 + c16, 0); fLab[1] = ld_rho(OFF_LAB, 32 + c16, 0); fLab[2] = ld_rho(OFF_LAB, 48 + c16, 0); fLab[3] = ld_rho(OFF_LAB, 48 + c16, 32);
#pragma unroll
                    for (int blk = 0; blk < 4; ++blk) fT[blk] = *(const LAS u32x2*)(lds + OFF_TBB + blk * 512 + c16 * 32 + q * 8);
                    __builtin_amdgcn_sched_barrier(0);
                    f32x4 U[4]; bf16x8 Ub0, Ub1;
                    U[0] = WK_MFMA(__builtin_bit_cast(bf16x8, ((u32x4){fT[0].x, fT[0].y, 0u, 0u})), packB(accA[0], z4), z4);
                    accA[1] = WK_MFMA(fLab[0], packB(U[0], z4), accA[1]);
                    U[1] = WK_MFMA(__builtin_bit_cast(bf16x8, ((u32x4){fT[1].x, fT[1].y, 0u, 0u})), packB(accA[1], z4), z4);
                    Ub0 = packB(U[0], U[1]);
                    accA[2] = WK_MFMA(fLab[1], Ub0, accA[2]);
                    U[2] = WK_MFMA(__builtin_bit_cast(bf16x8, ((u32x4){fT[2].x, fT[2].y, 0u, 0u})), packB(accA[2], z4), z4);
                    accA[3] = WK_MFMA(fLab[2], Ub0, accA[3]); accA[3] = WK_MFMA(fLab[3], packB(U[2], z4), accA[3]);
                    U[3] = WK_MFMA(__builtin_bit_cast(bf16x8, ((u32x4){fT[3].x, fT[3].y, 0u, 0u})), packB(accA[3], z4), z4);
                    Ub1 = packB(U[2], U[3]);
                    __builtin_amdgcn_sched_barrier(0);
                    bf16x8 fMrb[6], fB[8]; f32x4 gc[4];
                    fMrb[0] = ld_rho(OFF_MRB, c16, 0); fMrb[1] = ld_rho(OFF_MRB, 16 + c16, 0); fMrb[2] = ld_rho(OFF_MRB, 32 + c16, 0); fMrb[3] = ld_rho(OFF_MRB, 32 + c16, 32); fMrb[4] = ld_rho(OFF_MRB, 48 + c16, 0); fMrb[5] = ld_rho(OFF_MRB, 48 + c16, 32);
#pragma unroll
                    for (int kt = 0; kt < 4; ++kt) { fB[2 * kt] = ld_rho(OFF_BMT, 16 * kt + c16, 0); fB[2 * kt + 1] = ld_rho(OFF_BMT, 16 * kt + c16, 32); gc[kt] = *(const LAS f32x4*)(lds + OFF_GC + (16 * kt + 4 * q) * 4); }
                    __builtin_amdgcn_sched_barrier(0);
                    yv[0] = WK_MFMA(fMrb[0], Ub0, yv[0]); yv[1] = WK_MFMA(fMrb[1], Ub0, yv[1]);
                    yv[2] = WK_MFMA(fMrb[2], Ub0, yv[2]); yv[2] = WK_MFMA(fMrb[3], Ub1, yv[2]);
                    yv[3] = WK_MFMA(fMrb[4], Ub0, yv[3]); yv[3] = WK_MFMA(fMrb[5], Ub1, yv[3]);
#pragma unroll
                    for (int kt = 0; kt < 4; ++kt) { f32x4 a = WK_MFMA(fB[2 * kt], Ub0, sacc[kt]); a = WK_MFMA(fB[2 * kt + 1], Ub1, a); ST[kt] = a * gc[kt]; }
#pragma unroll
                    for (int blk = 0; blk < 4; ++blk)
#pragma unroll
                        for (int i = 0; i < 4; ++i) ((LAS float*)(lds + OFF_YB))[(16 * blk + 4 * q + i) * 65 + 16 * wave + c16] = yv[blk][i];
                }
                LDS_WAIT(); __builtin_amdgcn_s_barrier(); asm volatile("" ::: "memory");
            };
            for (int c2 = 0; c2 < SEQ / 64; c2 += 2) { chunk_body(c2, pfA); chunk_body(c2 + 1, pfB); }
            {
#pragma unroll
                for (int j = 0; j < 8; ++j) { const int tl = (SEQ / 64 - 1) * 64 + 8 * wave + j; const int t = fwd ? tl : SEQ - 1 - tl;
                    Yo[(rowbase + t) * D + col] = (bf16)cvt_pk_bf16(((const LAS float*)(lds + OFF_YB))[(8 * wave + j) * 65 + lane], 0.f); }
            }
            __syncthreads();
        }
#undef WK_NAT
#undef WK_MFMA
        __syncthreads();
    }
    SEAM(8);

    if (IN(9)) for (int rep_ = 0; rep_ < REP9; ++rep_) {
        const bf16* YF = (const bf16*)(ws + WS_Y); const bf16* YB = YF + (size_t)M * D;
        const bf16* RKV = (const bf16*)(ws + WS_RKV); const float* BS = (const float*)(ws + WS_BS); const bf16* GG = (const bf16*)(ws + WS_GG);
        bf16* PO = (bf16*)(ws + WS_PO);
        auto unpk = [](const u32x4& w, float (&f)[8]) {
#pragma unroll
            for (int i = 0; i < 4; ++i) { f[2 * i] = __uint_as_float(w[i] << 16); f[2 * i + 1] = __uint_as_float(w[i] & 0xffff0000u); } };
        auto row8_sum = [](float v) { v += dppmov<0xB1>(v); v += dppmov<0x4E>(v); v += dppmov<0x141>(v); return v; };
        for (int j = 0; j < 4; ++j) { const int cc = 8 * lane + 512 * j;
            float lw[8], lb[8];
#pragma unroll
            for (int i = 0; i < 8; ++i) { lw[i] = p.in[25][cc + i]; lb[i] = p.in[26][cc + i]; }
            for (int m = gw; m < M; m += NGW) { const size_t o = (size_t)m * D + cc;
                const u32x4 yfw = __builtin_nontemporal_load((const GAS u32x4*)(YF + o)), ybw = __builtin_nontemporal_load((const GAS u32x4*)(YB + o)), vw = __builtin_nontemporal_load((const GAS u32x4*)(RKV + (size_t)2 * M * D + o));
                const u32x4 gw4 = __builtin_nontemporal_load((const GAS u32x4*)(GG + o));
                const float bs = BS[(size_t)m * NH + (lane >> 3) + 8 * j];
                float yf[8], yb[8], vf[8], gf[8], y[8];
                unpk(yfw, yf); unpk(ybw, yb); unpk(vw, vf); unpk(gw4, gf);
                float s = 0.f;
#pragma unroll
                for (int i = 0; i < 8; ++i) { y[i] = yf[i] + yb[i]; s += y[i]; }
                const float mu = row8_sum(s) * (1.0f / 64.0f);
                float qv = 0.f;
#pragma unroll
                for (int i = 0; i < 8; ++i) { y[i] -= mu; qv += y[i] * y[i]; }
                const float rstd = 1.0f / sqrtf(row8_sum(qv) * (1.0f / 64.0f) + LNX_EPS);
                float ov[8];
#pragma unroll
                for (int i = 0; i < 8; ++i) ov[i] = (y[i] * rstd * lw[i] + lb[i] + vf[i] * bs) * gf[i];
                *(GAS u32x4*)(PO + o) = (u32x4){cvt_pk_bf16(ov[0], ov[1]), cvt_pk_bf16(ov[2], ov[3]), cvt_pk_bf16(ov[4], ov[5]), cvt_pk_bf16(ov[6], ov[7])}; }
        }
    }
    SEAM(9);

    if (IN(10)) {
        pg8::Gemm g{(const bf16*)(ws + WS_PO), (const bf16*)(ws + WS_WOT), D, D, D};
        SchedPlain S; S.T.init(M / 256, D / 256, G, bid); S.astep = (unsigned long long)256 * D * 2; S.bstep = (unsigned long long)256 * D * 2;
        pg8::EpiResid E{Hh};
        pg8::gemm_phase<pg8::EpiResid, SchedPlain, false, true>(lds, g, S, E);
    }
    SEAM(10);

    if (IN(11)) for (int rep_ = 0; rep_ < REP11; ++rep_) {
        {
            constexpr int NT_ = MOE_NT;
            auto ld_it = [&](int it, f32x4 (&v)[16]) { moe_cv_load(p.in, it, v, lane); };
            auto st_it = [&](int it, const f32x4 (&v)[16]) { moe_cv_store(ws, it, v, lane); };
            f32x4 va[16], vb[16];
            int it = MOE_CV_EARLY + MOE_CV_HALVES / 2 + gw; if (it < NT_) ld_it(it, va);
            while (it < NT_) {
                int n1 = it + NGW; if (n1 < NT_) ld_it(n1, vb);
                st_it(it, va); it = n1; if (it >= NT_) break;
                int n2 = it + NGW; if (n2 < NT_) ld_it(n2, va);
                st_it(it, vb); it = n2; }
        }
        __syncthreads();
        LAS float* rt = (LAS float*)lds;
        LAS int* lcnt = (LAS int*)(lds + 65536);
        for (int i = tid; i < D * NE; i += 512) { const int c = i >> 3, e = i & 7; const int l = (c & 511) >> 3, j = c >> 9, hf = (c >> 2) & 1, ii = c & 3; rt[((e * 4 + j) * 2 + hf) * 256 + l * 4 + ii] = p.in[28][i]; }
        unsigned char* HN2 = ws + WS_HN2; i32x4* SEL = (i32x4*)(ws + WS_SEL); int* CNT = (int*)(ws + WS_CNT);
        for (int chunk = bid; chunk < NCHUNK; chunk += G) {
            if (tid < 8) lcnt[tid] = 0;
            __syncthreads();
            for (int i = 0; i < 8; ++i) { const int m = chunk * 64 + wave * 8 + i;
                const bf16* xr = Hh + (size_t)m * D; f32x4 v[8]; float s = 0.f;
#pragma unroll
                for (int j = 0; j < 4; ++j) unpk8(__builtin_nontemporal_load((const GAS u32x4*)(xr + 8 * lane + 512 * j)), v[2 * j], v[2 * j + 1]);
#pragma unroll
                for (int j = 0; j < 8; ++j) s += (v[j].x * v[j].x + v[j].y * v[j].y) + (v[j].z * v[j].z + v[j].w * v[j].w);
                const float rsd = rstd_of(wave_sum(s));
                float lg[8];
#pragma unroll
                for (int e = 0; e < 8; ++e) lg[e] = 0.f;
#pragma unroll
                for (int j = 0; j < 4; ++j) { const f32x4 g0 = *(const GAS f32x4*)(p.in[27] + 8 * lane + 512 * j), g1 = *(const GAS f32x4*)(p.in[27] + 8 * lane + 512 * j + 4);
                    const f32x4 h0 = v[2 * j] * rsd * g0, h1 = v[2 * j + 1] * rsd * g1;
                    *(GAS u32x2*)(HN2 + (size_t)m * D + 8 * lane + 512 * j) = (u32x2){pk4_fp8(h0.x * F8_SA, h0.y * F8_SA, h0.z * F8_SA, h0.w * F8_SA), pk4_fp8(h1.x * F8_SA, h1.y * F8_SA, h1.z * F8_SA, h1.w * F8_SA)};
#pragma unroll
                    for (int e = 0; e < 8; ++e) { const f32x4 r0 = *(const LAS f32x4*)(rt + ((e * 4 + j) * 2) * 256 + lane * 4), r1 = *(const LAS f32x4*)(rt + ((e * 4 + j) * 2 + 1) * 256 + lane * 4);
                        lg[e] += ((h0.x * r0.x + h0.y * r0.y) + (h0.z * r0.z + h0.w * r0.w)) + ((h1.x * r1.x + h1.y * r1.y) + (h1.z * r1.z + h1.w * r1.w)); } }
#pragma unroll
                for (int e = 0; e < 8; ++e) lg[e] = wave_sum(lg[e]);
                int e1 = 0; float v1 = lg[0];
#pragma unroll
                for (int e = 1; e < 8; ++e) if (lg[e] > v1) { v1 = lg[e]; e1 = e; }
                int e2 = -1; float v2 = -3.0e38f;
#pragma unroll
                for (int e = 0; e < 8; ++e) if (e != e1 && lg[e] > v2) { v2 = lg[e]; e2 = e; }
                const float g1 = 1.0f / (1.0f + expf(v2 - v1)), g2 = 1.0f - g1;
                if (lane == 0) { SEL[m] = (i32x4){e1 | (e2 << 8), __float_as_int(g1), __float_as_int(g2), 0}; atomicAdd((int*)&lcnt[e1], 1); atomicAdd((int*)&lcnt[e2], 1); }
            }
            __syncthreads();
            if (tid < 8) CNT[chunk * 8 + tid] = lcnt[tid];
            __syncthreads();
        }
    }
    SEAM(11);

    if (IN(12)) for (int rep_ = 0; rep_ < REP12; ++rep_) {
        LAS int* pre = (LAS int*)lds;
        LAS int* tot = pre + NCHUNK * 8;
        LAS int* posb = tot + 32;
        const int* CNT = (const int*)(ws + WS_CNT); const i32x4* SEL = (const i32x4*)(ws + WS_SEL);
        i32x2* META = (i32x2*)(ws + WS_META); unsigned* TILEE = (unsigned*)(ws + WS_TILEE);
        const unsigned char* HN2 = ws + WS_HN2; unsigned char* AG = ws + WS_AG;
        for (int i = tid; i < NCHUNK * 8; i += 512) pre[i] = CNT[i];
        __syncthreads();
        {
            const int e = wave; int v4[4]; int t4 = 0;
#pragma unroll
            for (int k = 0; k < 4; ++k) { v4[k] = pre[(4 * lane + k) * 8 + e]; t4 += v4[k]; }
            int incl = t4;
#pragma unroll
            for (int o = 1; o < 64; o <<= 1) { const int u = __shfl_up(incl, o); if (lane >= o) incl += u; }
            int run = incl - t4;
#pragma unroll
            for (int k = 0; k < 4; ++k) { pre[(4 * lane + k) * 8 + e] = run; run += v4[k]; }
            if (lane == 63) tot[e] = incl; }
        __syncthreads();
        if (tid == 0) { int base = 0; for (int e = 0; e < 8; ++e) { const int nt_ = (tot[e] + 255) >> 8; tot[8 + e] = base; tot[16 + e] = nt_; base += nt_ * 256; } tot[24] = base >> 8; }
        __syncthreads();
        if (bid == 0) {
            if (tid == 0) { int ti = 0; for (int e = 0; e < 8; ++e) for (int k = 0; k < tot[16 + e]; ++k) TILEE[ti++] = (unsigned)e; TILEE[200] = (unsigned)tot[24]; }
        }
        for (int e = bid; e < 8; e += G) { const int pbeg = tot[8 + e] + tot[e], pend = tot[8 + e] + tot[16 + e] * 256;
            for (int r = pbeg + wave; r < pend; r += 8) { if (lane == 0) META[r] = (i32x2){-1, 0};
#pragma unroll
                for (int j = 0; j < 2; ++j) *((GAS u32x4*)(AG + (size_t)r * D) + lane + 64 * j) = (u32x4){0u, 0u, 0u, 0u}; } }
        for (int chunk = bid; chunk < NCHUNK; chunk += G) {
            if (wave == 0) { const int m = chunk * 64 + lane; const i32x4 s = SEL[m]; const int e1 = s.x & 0xff, e2 = (s.x >> 8) & 0xff;
                int p1 = 0, p2 = 0;
#pragma unroll
                for (int e = 0; e < 8; ++e) { const unsigned long long mk = __ballot((e1 == e) || (e2 == e)); const int rank = __popcll(mk & ((1ull << lane) - 1ull)); const int pos = tot[8 + e] + pre[chunk * 8 + e] + rank; if (e1 == e) p1 = pos; if (e2 == e) p2 = pos; }
                posb[2 * lane] = p1; posb[2 * lane + 1] = p2; ((i32x2*)(ws + WS_POS))[m] = (i32x2){p1, p2};
                META[p1] = (i32x2){m, s.y}; META[p2] = (i32x2){m | (1 << 14), s.z}; }
            __syncthreads();
            for (int q = 0; q < 16; ++q) { const int idx = wave * 16 + q; const int m = chunk * 64 + (idx >> 1); const int pos = posb[idx];
                const GAS u32x4* src = (const GAS u32x4*)(HN2 + (size_t)m * D) + lane; GAS u32x4* dst = (GAS u32x4*)(AG + (size_t)pos * D) + lane;
#pragma unroll
                for (int j = 0; j < 2; ++j) dst[64 * j] = __builtin_nontemporal_load(src + 64 * j); }
            __syncthreads();
        }
    }
    SEAM(12);

    if (IN(13)) for (int rep_ = 0; rep_ < REP13; ++rep_) {
        const unsigned* TILEE = (const unsigned*)(ws + WS_TILEE);
        const int ntiles = (int)__builtin_amdgcn_readfirstlane(__hip_atomic_load(TILEE + 200, __ATOMIC_RELAXED, __HIP_MEMORY_SCOPE_AGENT));
        LAS unsigned* tl = (LAS unsigned*)(lds + 131072);
        if (tid < MAXTILES) tl[tid] = __hip_atomic_load(TILEE + tid, __ATOMIC_RELAXED, __HIP_MEMORY_SCOPE_AGENT);
        __syncthreads();
        pg8::Gemm g{(const bf16*)(ws + WS_AG), (const bf16*)(ws + WS_WGUT), D / 2, D / 2, D / 2};
        SchedMoe S; S.T.init(ntiles, 2 * FFE / 256, G, bid); S.tile_e = tl; S.astep = (unsigned long long)256 * D; S.bstep = (unsigned long long)256 * D; S.nN = 2 * FFE / 256;
        pg8::EpiSwigluF8 E{ws + WS_ACT1, FFE, 1.0f / (F8_SA * F8_SWU)};
        pg8::gemm_phase<pg8::EpiSwigluF8, SchedMoe, true, true, true>(lds, g, S, E);
    }
    SEAM(13);

    if (IN(14)) for (int rep_ = 0; rep_ < REP14; ++rep_) {
        const unsigned* TILEE = (const unsigned*)(ws + WS_TILEE);
        const int ntiles = (int)__builtin_amdgcn_readfirstlane(__hip_atomic_load(TILEE + 200, __ATOMIC_RELAXED, __HIP_MEMORY_SCOPE_AGENT));
        LAS unsigned* tl = (LAS unsigned*)(lds + 131072);
        if (tid < MAXTILES) tl[tid] = __hip_atomic_load(TILEE + tid, __ATOMIC_RELAXED, __HIP_MEMORY_SCOPE_AGENT);
        __syncthreads();
        pg8::EpiMoeDown E{(const i32x2*)(ws + WS_META), (bf16*)(ws + WS_YM), (bf16*)(ws + WS_P2), 1.0f / (F8_SH * F8_SWD)};
        {
            pg8::Gemm g{(const bf16*)(ws + WS_ACT1), (const bf16*)(ws + WS_WDT), FFE / 2, FFE / 2, FFE / 2};
            SchedMoe S; S.T.init(128, D / 256, G, bid); S.tile_e = tl; S.astep = (unsigned long long)256 * FFE; S.bstep = (unsigned long long)256 * FFE; S.nN = D / 256;
            pg8::gemm_phase<pg8::EpiMoeDown, SchedMoe, true, true, true>(lds, g, S, E);
        }
        {
            pg8::Gemm g{(const bf16*)(ws + WS_ACT1), (const bf16*)(ws + WS_WDT), FFE / 2, FFE / 2, KQ / 2};
            SchedMoeTail S; S.nq = (ntiles - 128) * 32; S.G = G; S.c = bid; S.tile_e = tl;
            pg8::gemm_phase<pg8::EpiMoeDown, SchedMoeTail, true, true, true>(lds, g, S, E);
        }
    }
    SEAM(14);

    if (IN(15)) for (int rep_ = 0; rep_ < REP15; ++rep_) {
        const bf16* Y0 = (const bf16*)(ws + WS_YM); const bf16* Y1 = Y0 + (size_t)M * D; const bf16* P2b = (const bf16*)(ws + WS_P2);
        auto addbf = [](f32x4& a, f32x4& c, const u32x4 w) {
            a = a + (f32x4){__uint_as_float(w.x << 16), __uint_as_float(w.x & 0xffff0000u), __uint_as_float(w.y << 16), __uint_as_float(w.y & 0xffff0000u)};
            c = c + (f32x4){__uint_as_float(w.z << 16), __uint_as_float(w.z & 0xffff0000u), __uint_as_float(w.w << 16), __uint_as_float(w.w & 0xffff0000u)}; };
        for (int m = gw; m < M; m += NGW) {
            const i32x2 ps = ((const i32x2*)(ws + WS_POS))[m];
            const int pq0 = __builtin_amdgcn_readfirstlane(ps.x), pq1 = __builtin_amdgcn_readfirstlane(ps.y);
            f32x4 v[8]; float s = 0.f;
#pragma unroll
            for (int j = 0; j < 4; ++j) { const size_t o = (size_t)m * D + 8 * lane + 512 * j;
                unpk8(__builtin_nontemporal_load((const GAS u32x4*)(Hh + o)), v[2 * j], v[2 * j + 1]);
                addbf(v[2 * j], v[2 * j + 1], __builtin_nontemporal_load((const GAS u32x4*)(Y0 + o))); addbf(v[2 * j], v[2 * j + 1], __builtin_nontemporal_load((const GAS u32x4*)(Y1 + o))); }
            for (int sl = 0; sl < 2; ++sl) { const int pq = sl ? pq1 : pq0;
                if (pq >= SPLIT_ROW0) {
                    for (int qq = 0; qq < 3; ++qq) { const bf16* pr = P2b + ((size_t)qq * 2048 + (pq - SPLIT_ROW0)) * D + 8 * lane;
#pragma unroll
                        for (int j = 0; j < 4; ++j) addbf(v[2 * j], v[2 * j + 1], *(const GAS u32x4*)(pr + 512 * j)); } } }
#pragma unroll
            for (int j = 0; j < 8; ++j) s += (v[j].x * v[j].x + v[j].y * v[j].y) + (v[j].z * v[j].z + v[j].w * v[j].w);
            const float rsd = rstd_of(wave_sum(s));
#pragma unroll
            for (int j = 0; j < 4; ++j) { const size_t o = (size_t)m * D + 8 * lane + 512 * j; const f32x4 g0 = *(const GAS f32x4*)(p.in[32] + 8 * lane + 512 * j), g1 = *(const GAS f32x4*)(p.in[32] + 8 * lane + 512 * j + 4);
                __builtin_nontemporal_store(v[2 * j] * rsd * g0, (GAS f32x4*)(p.out + o)); __builtin_nontemporal_store(v[2 * j + 1] * rsd * g1, (GAS f32x4*)(p.out + o + 4)); }
        }
    }
#undef IN
#undef SEAM
}

#ifndef MK_N_LAUNCHES
#define MK_N_LAUNCHES 1
#endif
constexpr int N_PHASES = 16;
extern "C" void kernel_launch(void* const* d_in, const int* in_sizes, int n_in, void* d_out, int out_size, void* d_ws, size_t ws_size, hipStream_t stream) {
    static int grid = 0;
    if (grid == 0) {
        if (n_in != 33 || out_size != M * D || ws_size < WS_END) { fprintf(stderr, "kernel_launch: unexpected shapes: n_in %d out %d ws %zu (need %zu)\n", n_in, out_size, ws_size, (size_t)WS_END); grid = -1; return; }
        int dev = 0, cus = 0, per_cu = 0;
        if (hipGetDevice(&dev) != hipSuccess || hipDeviceGetAttribute(&cus, hipDeviceAttributeMultiprocessorCount, dev) != hipSuccess) { grid = -1; return; }
        if (hipFuncSetAttribute((const void*)fwd_kernel, hipFuncAttributeMaxDynamicSharedMemorySize, LDS_BYTES) != hipSuccess) { fprintf(stderr, "kernel_launch: hipFuncSetAttribute failed\n"); grid = -1; return; }
        if (hipOccupancyMaxActiveBlocksPerMultiprocessor(&per_cu, (const void*)fwd_kernel, 512, LDS_BYTES) != hipSuccess || per_cu < 1) { fprintf(stderr, "kernel_launch: occupancy query says %d\n", per_cu); (void)hipGetLastError(); }
        grid = cus;
        if (grid < 2 * BATCH * NH) { fprintf(stderr, "kernel_launch: needs >= 256 CUs (one WKV scan per workgroup), got %d\n", grid); grid = -1; return; }
    }
    if (grid < 0) return;
    (void)hipMemsetAsync((char*)d_ws + WS_CTL, 0, CTL_ZERO_BYTES, stream);
    Params p{};
    for (int i = 0; i < 33; ++i) p.in[i] = (const float*)d_in[i];
    p.out = (float*)d_out; p.ws = (unsigned char*)d_ws;
#if MK_N_LAUNCHES == 1
    p.ph_lo = 0; p.ph_hi = N_PHASES;
    hipLaunchKernelGGL(fwd_kernel, dim3(grid), dim3(512), LDS_BYTES, stream, p);
#else
    for (int k = 0; k < N_PHASES; ++k) { p.ph_lo = k; p.ph_hi = k + 1; hipLaunchKernelGGL(fwd_kernel, dim3(grid), dim3(512), LDS_BYTES, stream, p); }
#endif
}
```

```cpp
#include <hip/hip_runtime.h>
#include <cstdio>

#define GAS __attribute__((address_space(1)))
#define LAS __attribute__((address_space(3)))
typedef unsigned short bf16;
typedef short bf16x8 __attribute__((ext_vector_type(8)));
typedef float f32x2 __attribute__((ext_vector_type(2)));
typedef float f32x4 __attribute__((ext_vector_type(4)));
typedef float f32x16 __attribute__((ext_vector_type(16)));
typedef unsigned u32x2 __attribute__((ext_vector_type(2)));
typedef unsigned u32x4 __attribute__((ext_vector_type(4)));
typedef int i32x4 __attribute__((ext_vector_type(4)));
typedef int i32x2 __attribute__((ext_vector_type(2)));
typedef int i32x8 __attribute__((ext_vector_type(8)));

constexpr int D = 2048, BATCH = 4, SEQ = 4096, M = BATCH * SEQ, NH = 32, HS = 64;
constexpr int FF0 = 5632, FFE = 7168, NE = 8, LOR = 96, LOG = 256;
constexpr float RMS_EPS = 1e-6f, LNX_EPS = 64e-5f;
constexpr int NCHUNK = M / 64;
constexpr int MAXTILES = 2 * M / 256 + NE;
constexpr int MAXROWS = MAXTILES * 256;

constexpr size_t MiB = (size_t)1 << 20;
constexpr size_t WS_CTL = 0, CTL_ZERO_BYTES = 64 * 1024;
constexpr size_t WS_CNT = 1 * MiB;
constexpr size_t WS_TILEE = WS_CNT + 16 * 1024;
constexpr size_t WS_SEL = WS_CNT + 32 * 1024;
constexpr size_t WS_META = WS_SEL + (size_t)M * 16;
constexpr size_t WS_PART = 256 * 1024;
constexpr size_t WS_POS = WS_META + (size_t)MAXROWS * 8;
constexpr size_t WS_POOLT = 2 * MiB;
constexpr size_t WS_FFN1T = 4 * MiB;
constexpr size_t WS_FFN2T = 48 * MiB;
constexpr size_t WS_RKVLOT = 70 * MiB;
constexpr size_t WS_WOT = 97 * MiB;
constexpr size_t WS_DW2T = 105 * MiB;
constexpr size_t WS_AW2T = WS_DW2T + (size_t)2 * 2048 * 96 * 2;
constexpr size_t WS_G2T = 107 * MiB;
constexpr size_t WS_H = 108 * MiB;
constexpr size_t WS_G = 236 * MiB;
constexpr size_t WS_POOLED = WS_G, WS_HN = WS_G + 64 * MiB, WS_ACT0 = WS_G + 128 * MiB;
constexpr size_t WS_MIX = WS_G;
constexpr size_t WS_RKV = WS_G + 384 * MiB;
constexpr size_t WS_LO = WS_G + 576 * MiB;
constexpr size_t WS_EW = WS_G + 600 * MiB;
constexpr size_t WS_AA = WS_G + 728 * MiB;
constexpr size_t WS_GG = WS_G + 856 * MiB;
constexpr size_t WS_Y = WS_G;
constexpr size_t WS_PO = WS_G + 256 * MiB;
constexpr size_t WS_BS = WS_G + 128 * MiB;
constexpr size_t WS_HN2 = WS_G;
constexpr size_t WS_P2 = WS_G;
constexpr int SPLIT_ROW0 = 128 * 256, KQ = FFE / 4;
constexpr size_t WS_AG = WS_G + 64 * MiB;
constexpr size_t WS_WGUT = WS_G + 920 * MiB;
constexpr size_t WS_WDT = WS_G + 1144 * MiB;
constexpr size_t WS_ACT1 = WS_G + 200 * MiB;
constexpr size_t WS_YM = WS_G + 448 * MiB;
constexpr size_t WS_END = WS_WDT + (size_t)NE * FFE * D;
static_assert(WS_AG + (size_t)MAXROWS * D <= WS_ACT1 && WS_ACT1 + (size_t)MAXROWS * FFE <= WS_YM && WS_YM + (size_t)2 * M * D * 2 <= WS_WGUT && WS_WGUT + (size_t)NE * 2 * FFE * D <= WS_WDT, "moe map");
static_assert(WS_EW + (size_t)2 * M * D * 2 <= WS_AA && WS_AA + (size_t)2 * M * D * 2 <= WS_GG && WS_GG + (size_t)M * D * 2 <= WS_WGUT && WS_END <= (size_t)1600 * MiB, "ws map");
static_assert(WS_PART + (size_t)M * 32 <= WS_CNT && WS_POS + (size_t)M * 8 <= WS_POOLT && WS_G2T + (size_t)2048 * 256 * 2 <= WS_H, "ws small map");

constexpr int LDS_BYTES = 147456;
constexpr int MISC_OFF = LDS_BYTES - 256;

__device__ __forceinline__ float bf2f(unsigned short b) { return __uint_as_float(((unsigned)b) << 16); }
typedef __bf16 bf16v2_t __attribute__((ext_vector_type(2)));
__device__ __forceinline__ unsigned cvt_pk_bf16(float lo, float hi) { const f32x2 v = (f32x2){lo, hi}; return __builtin_bit_cast(unsigned, __builtin_convertvector(v, bf16v2_t)); }
__device__ __forceinline__ void unpk8(const u32x4 w, f32x4& a, f32x4& c) {
    a = (f32x4){__uint_as_float(w.x << 16), __uint_as_float(w.x & 0xffff0000u), __uint_as_float(w.y << 16), __uint_as_float(w.y & 0xffff0000u)};
    c = (f32x4){__uint_as_float(w.z << 16), __uint_as_float(w.z & 0xffff0000u), __uint_as_float(w.w << 16), __uint_as_float(w.w & 0xffff0000u)}; }
__device__ __forceinline__ unsigned pk4_fp8(float a, float b, float c, float d) {
    a = fminf(fmaxf(a, -448.f), 448.f); b = fminf(fmaxf(b, -448.f), 448.f); c = fminf(fmaxf(c, -448.f), 448.f); d = fminf(fmaxf(d, -448.f), 448.f);
    int w = 0; w = __builtin_amdgcn_cvt_pk_fp8_f32(a, b, w, false); w = __builtin_amdgcn_cvt_pk_fp8_f32(c, d, w, true); return (unsigned)w; }
constexpr float F8_SA = 32.f, F8_SWU = 1024.f;
constexpr float F8_SH = 8.f, F8_SWD = 4096.f;
constexpr bool FFN_DOWN_FP8 = true;
constexpr float F8_SH0 = 8.f, F8_SWD0 = 4096.f;
template <int CTRL> __device__ __forceinline__ float dppmov(float v) { return __int_as_float(__builtin_amdgcn_update_dpp(0, __float_as_int(v), CTRL, 0xf, 0xf, true)); }
__device__ __forceinline__ float row16_sum(float v) {
    v += dppmov<0xB1>(v);
    v += dppmov<0x4E>(v);
    v += dppmov<0x141>(v);
    v += dppmov<0x140>(v);
    return v;
}
__device__ __forceinline__ float wave_sum(float v) {
    v = row16_sum(v);
    v += __int_as_float(__builtin_amdgcn_update_dpp(0, __float_as_int(v), 0x142, 0xa, 0xf, false));
    v += __int_as_float(__builtin_amdgcn_update_dpp(0, __float_as_int(v), 0x143, 0xc, 0xf, false));
    return __int_as_float(__builtin_amdgcn_readlane(__float_as_int(v), 63));
}
__device__ __forceinline__ float sigmoidf_(float x) { return __builtin_amdgcn_rcpf(1.0f + __expf(-x)); }
#define LDS_WAIT() asm volatile("s_waitcnt lgkmcnt(0)" ::: "memory")
#define VM_WAIT() asm volatile("s_waitcnt vmcnt(0)" ::: "memory")

namespace pg8 {
constexpr int BM = 256, BK = 64, HALF = 128, HTB = HALF * BK * 2, STAGE_BYTES = 8 * HTB, NXCD = 8, WGM = 4;
__host__ __device__ __forceinline__ int lds_byte(int r, int c) { const int st = (r >> 4) * 2 + (c >> 5), rr = r & 15, cc = c & 31, ob = rr * 64 + cc * 2; return st * 1024 + (ob ^ (((ob >> 9) & 1) << 5)); }
__host__ __device__ __forceinline__ void stage_rc(int b, int& R, int& C) { const int st = b / 1024, sb = b % 1024, swz = sb ^ (((sb >> 9) & 1) << 5); R = (st >> 1) * 16 + swz / 64; C = (st & 1) * 32 + (swz % 64) / 2; }
__host__ __device__ __forceinline__ int perm32(int rho) { const int n = rho >> 4, i = rho & 15; return 8 * (i >> 2) + 4 * n + (i & 3); }

struct Unit { int pm, pn, aux; unsigned long long aoff, boff; };
struct Gemm { const bf16* A; const bf16* Bt; int lda, ldb, K; };

struct TileOrder {
    int nM, nN, nwg, G, c, wgm;
    __device__ __forceinline__ void init(int nM_, int nN_, int G_, int c_, int wgm_ = WGM) { nM = nM_; nN = nN_; nwg = nM * nN; G = G_; c = c_; wgm = wgm_; }
    __device__ __forceinline__ bool map(int i, int& pm, int& pn) const {
        const long L = (long)i * G + c; if (L >= nwg) return false;
        int wgid = (int)L; { const int q = nwg / NXCD, r = nwg % NXCD, xcd = wgid % NXCD, off = wgid / NXCD; wgid = (xcd < r ? xcd * (q + 1) : r * (q + 1) + (xcd - r) * q) + off; }
        const int nig = wgm * nN, gid = wgid / nig, fm = gid * wgm, gsz = (nM - fm) < wgm ? (nM - fm) : wgm;
        pm = fm + ((wgid % nig) % gsz); pn = (wgid % nig) / gsz; return true;
    }
};

template <class Epi, class Sched, bool ALIGN_EPI = true, bool SP2 = true, bool FP8 = false>
__device__ __forceinline__ void gemm_phase(LAS unsigned char* lds, const Gemm g, const Sched& S, const Epi& E) {
    const int tid = threadIdx.x, wid = __builtin_amdgcn_readfirstlane(tid >> 6), lane = tid & 63, wr = wid >> 2, wc = wid & 3, fr = lane & 15, fq = lane >> 4;
    const int K = g.K, nt = K / BK;
    unsigned voffA[2], voffB[2];
#pragma unroll
    for (int i = 0; i < 2; ++i) { int R, C; stage_rc(tid * 16 + i * 8192, R, C); const int Rb = Epi::PERM ? ((R & ~31) + perm32(R & 31)) : R;
        voffA[i] = (unsigned)(R * g.lda + C) * 2u; voffB[i] = (unsigned)(Rb * g.ldb + C) * 2u; }
    const size_t kstep = (size_t)(BK * 2);
    const size_t hstepA = (size_t)HALF * g.lda * 2, hstepB = (size_t)HALF * g.ldb * 2;
    const unsigned ldsw = (unsigned)wid * 1024u;
    const int aoff = lds_byte(wr * 64 + fr, fq * 8), boff = lds_byte(wc * 32 + fr, fq * 8);
#define PG8_SA(b, h) (((b) * 2 + (h)) * HTB)
#define PG8_SB(b, h) ((4 + (b) * 2 + (h)) * HTB)
#define PG8_STAGE(bufoff, gbase, voff) do { _Pragma("unroll") for (int _i = 0; _i < 2; ++_i) \
        __builtin_amdgcn_global_load_lds((const unsigned*)((const char*)(gbase) + (voff)[_i]), (LAS unsigned*)(lds + (bufoff) + ldsw + _i * 8192), 16, 0, 0); } while (0)
#define PG8_LD8(off) __builtin_bit_cast(i32x8, __builtin_shufflevector(*(const LAS u32x4*)(lds + (off)), *(const LAS u32x4*)(lds + (off) + 1024), 0, 1, 2, 3, 4, 5, 6, 7))
#define PG8_LDA(dst, b, h) do { if constexpr (FP8) { _Pragma("unroll") for (int m = 0; m < 4; ++m) dst##8[m] = PG8_LD8(PG8_SA(b, h) + aoff + m * 2048); } \
        else { _Pragma("unroll") for (int m = 0; m < 4; ++m) _Pragma("unroll") for (int k = 0; k < 2; ++k) dst[m][k] = *(const LAS bf16x8*)(lds + PG8_SA(b, h) + aoff + m * 2048 + k * 1024); } } while (0)
#define PG8_LDB(dst, b, h) do { if constexpr (FP8) { _Pragma("unroll") for (int n = 0; n < 2; ++n) dst##8[n] = PG8_LD8(PG8_SB(b, h) + boff + n * 2048); } \
        else { _Pragma("unroll") for (int n = 0; n < 2; ++n) _Pragma("unroll") for (int k = 0; k < 2; ++k) dst[n][k] = *(const LAS bf16x8*)(lds + PG8_SB(b, h) + boff + n * 2048 + k * 1024); } } while (0)
#define PG8_MMA(ai, bj, At, Bt) do { __builtin_amdgcn_s_setprio(1); _Pragma("unroll") for (int m = 0; m < 4; ++m) _Pragma("unroll") for (int n = 0; n < 2; ++n) { \
        if constexpr (FP8) asm volatile("v_mfma_scale_f32_16x16x128_f8f6f4 %0, %1, %2, %0, %3, %3 op_sel_hi:[0,0,0]" : "+v"(acc[ai][bj][m][n]) : "v"(Bt##8[n]), "v"(At##8[m]), "v"(f8scale)); \
        else { _Pragma("unroll") for (int k = 0; k < 2; ++k) acc[ai][bj][m][n] = __builtin_amdgcn_mfma_f32_16x16x32_bf16(Bt[n][k], At[m][k], acc[ai][bj][m][n], 0, 0, 0); } } __builtin_amdgcn_s_setprio(0); } while (0)
#define PG8_WAIT_V(n) asm volatile("s_waitcnt vmcnt(" #n ")" ::: "memory")
#define PG8_WAIT_L(n) asm volatile("s_waitcnt lgkmcnt(" #n ")" ::: "memory")
#define PG8_BAR __builtin_amdgcn_s_barrier()
#define PG8_SCHED __builtin_amdgcn_sched_barrier(0)
    Unit cur, nxt; int ui = 0;
    if (!S.next(0, cur)) return;
    f32x4 acc[2][2][4][2];
#pragma unroll
    for (int a = 0; a < 2; ++a)
#pragma unroll
        for (int b = 0; b < 2; ++b)
#pragma unroll
            for (int m = 0; m < 4; ++m)
#pragma unroll
                for (int n = 0; n < 2; ++n) acc[a][b][m][n] = (f32x4){0.f, 0.f, 0.f, 0.f};
    bf16x8 At[4][2], B0[2][2], B1[2][2]; i32x8 At8[4], B08[2], B18[2];
    const int f8scale = 0x7f7f7f7f;
    const char* cA = (const char*)g.A + cur.aoff; const char* cB = (const char*)g.Bt + cur.boff;
    if constexpr (SP2) {
        PG8_STAGE(PG8_SB(0, 0), cB, voffB); PG8_STAGE(PG8_SB(0, 1), cB + hstepB, voffB); PG8_STAGE(PG8_SA(0, 0), cA, voffA); PG8_STAGE(PG8_SA(0, 1), cA + hstepA, voffA);
        if (wr == 1) PG8_BAR;
        PG8_WAIT_V(2); PG8_BAR;
        PG8_STAGE(PG8_SB(1, 0), cB + kstep, voffB); PG8_STAGE(PG8_SA(1, 0), cA + kstep, voffA); PG8_STAGE(PG8_SB(1, 1), cB + hstepB + kstep, voffB);
        PG8_WAIT_V(6); PG8_BAR;
    } else {
        PG8_STAGE(PG8_SB(0, 0), cB, voffB); PG8_STAGE(PG8_SA(0, 0), cA, voffA); PG8_STAGE(PG8_SB(0, 1), cB + hstepB, voffB); PG8_STAGE(PG8_SA(0, 1), cA + hstepA, voffA);
        if (wr == 1) PG8_BAR;
        PG8_WAIT_V(4); PG8_BAR;
        PG8_STAGE(PG8_SB(1, 0), cB + kstep, voffB); PG8_STAGE(PG8_SA(1, 0), cA + kstep, voffA); PG8_STAGE(PG8_SB(1, 1), cB + hstepB + kstep, voffB);
        PG8_WAIT_V(6); PG8_BAR;
    }
    for (;;) {
        const bool has_next = S.next(ui + 1, nxt);
        const char* nA = has_next ? (const char*)g.A + nxt.aoff : cA; const char* nB = has_next ? (const char*)g.Bt + nxt.boff : cB;
        for (int t = 0; t < nt; t += 2) {
            const bool last = (t == nt - 2);
            const char* a1 = cA + (size_t)(t + 1) * kstep;
            const char* a2 = last ? nA : cA + (size_t)(t + 2) * kstep; const char* b2 = last ? nB : cB + (size_t)(t + 2) * kstep;
            const char* a3 = a2 + kstep; const char* b3 = b2 + kstep;
            if constexpr (SP2) {
            PG8_LDB(B0, 0, 0); PG8_LDB(B1, 0, 1); PG8_SCHED; PG8_LDA(At, 0, 0); PG8_STAGE(PG8_SA(1, 1), a1 + hstepA, voffA);
            PG8_WAIT_V(8); PG8_WAIT_L(0); PG8_BAR; PG8_MMA(0, 0, At, B0); PG8_MMA(0, 1, At, B1); PG8_BAR; PG8_SCHED;
            PG8_LDA(At, 0, 1); PG8_STAGE(PG8_SB(0, 0), b2, voffB); PG8_STAGE(PG8_SB(0, 1), b2 + hstepB, voffB); PG8_STAGE(PG8_SA(0, 0), a2, voffA);
            PG8_WAIT_V(8); PG8_WAIT_L(0); PG8_BAR; PG8_MMA(1, 0, At, B0); PG8_MMA(1, 1, At, B1); PG8_BAR; PG8_SCHED;
            PG8_LDB(B0, 1, 0); PG8_LDB(B1, 1, 1); PG8_SCHED; PG8_LDA(At, 1, 0); PG8_STAGE(PG8_SA(0, 1), a2 + hstepA, voffA);
            PG8_WAIT_V(8); PG8_WAIT_L(0); PG8_BAR; PG8_MMA(0, 0, At, B0); PG8_MMA(0, 1, At, B1); PG8_BAR; PG8_SCHED;
            PG8_LDA(At, 1, 1); PG8_STAGE(PG8_SB(1, 0), b3, voffB); PG8_STAGE(PG8_SB(1, 1), b3 + hstepB, voffB); PG8_STAGE(PG8_SA(1, 0), a3, voffA);
            PG8_WAIT_V(8); PG8_WAIT_L(0); PG8_BAR; PG8_MMA(1, 0, At, B0); PG8_MMA(1, 1, At, B1); PG8_BAR; PG8_SCHED;
            } else {
            PG8_LDB(B0, 0, 0); PG8_SCHED; PG8_LDA(At, 0, 0); PG8_STAGE(PG8_SA(1, 1), a1 + hstepA, voffA);
            PG8_WAIT_L(8); PG8_BAR; PG8_WAIT_L(0); PG8_MMA(0, 0, At, B0); PG8_BAR; PG8_SCHED;
            PG8_LDB(B1, 0, 1); PG8_STAGE(PG8_SB(0, 0), b2, voffB);
            PG8_BAR; PG8_WAIT_L(0); PG8_MMA(0, 1, At, B1); PG8_BAR;
            PG8_LDA(At, 0, 1); PG8_STAGE(PG8_SA(0, 0), a2, voffA);
            PG8_BAR; PG8_WAIT_L(0); PG8_MMA(1, 0, At, B0); PG8_BAR; PG8_SCHED;
            PG8_STAGE(PG8_SB(0, 1), b2 + hstepB, voffB);
            PG8_WAIT_V(6); PG8_BAR; PG8_MMA(1, 1, At, B1); PG8_BAR;
            PG8_LDB(B0, 1, 0); PG8_SCHED; PG8_LDA(At, 1, 0); PG8_STAGE(PG8_SA(0, 1), a2 + hstepA, voffA);
            PG8_WAIT_L(8); PG8_BAR; PG8_WAIT_L(0); PG8_MMA(0, 0, At, B0); PG8_BAR; PG8_SCHED;
            PG8_LDB(B1, 1, 1); PG8_STAGE(PG8_SB(1, 0), b3, voffB);
            PG8_BAR; PG8_WAIT_L(0); PG8_MMA(0, 1, At, B1); PG8_BAR;
            PG8_LDA(At, 1, 1); PG8_STAGE(PG8_SA(1, 0), a3, voffA);
            PG8_BAR; PG8_WAIT_L(0); PG8_MMA(1, 0, At, B0); PG8_BAR; PG8_SCHED;
            PG8_STAGE(PG8_SB(1, 1), b3 + hstepB, voffB);
            PG8_WAIT_V(6); PG8_BAR; PG8_MMA(1, 1, At, B1); PG8_BAR;
            }
        }
        if constexpr (ALIGN_EPI) { if (wr == 0) PG8_BAR; }
        if constexpr (FP8) {
            asm volatile("s_nop 15\n\ts_nop 3" ::: "memory");
#pragma unroll
            for (int a = 0; a < 2; ++a)
#pragma unroll
                for (int b = 0; b < 2; ++b)
#pragma unroll
                    for (int m = 0; m < 4; ++m)
#pragma unroll
                        for (int n = 0; n < 2; ++n) asm volatile("" : "+v"(acc[a][b][m][n])); }
        E(acc, cur, wr, wc, fr, fq);
        if (!has_next) break;
#pragma unroll
        for (int a = 0; a < 2; ++a)
#pragma unroll
            for (int b = 0; b < 2; ++b)
#pragma unroll
                for (int m = 0; m < 4; ++m)
#pragma unroll
                    for (int n = 0; n < 2; ++n) acc[a][b][m][n] = (f32x4){0.f, 0.f, 0.f, 0.f};
        cur = nxt; cA = nA; cB = nB; ++ui;
        if constexpr (ALIGN_EPI) { if (wr == 1) PG8_BAR; }
    }
    PG8_WAIT_V(0);
    if constexpr (!ALIGN_EPI) { if (wr == 0) PG8_BAR; }
    PG8_BAR;
#undef PG8_SA
#undef PG8_SB
#undef PG8_STAGE
#undef PG8_LDA
#undef PG8_LDB
#undef PG8_MMA
#undef PG8_LD8
#undef PG8_WAIT_V
#undef PG8_WAIT_L
#undef PG8_BAR
#undef PG8_SCHED
}

struct EpiPool {
    static constexpr bool PERM = true;
    const float* X; bf16* Hh; const float* scale; LAS float* red; float* part;
    __device__ __forceinline__ void operator()(const f32x4 (&acc)[2][2][4][2], const Unit& u, int wr, int wc, int fr, int fq) const {
        const int row0 = u.pm * BM + wr * 64 + fr, col0 = u.pn * BM + wc * 32 + 8 * fq;
        float ss[2][4];
        f32x4 sv[2][2];
#pragma unroll
        for (int bj = 0; bj < 2; ++bj)
#pragma unroll
            for (int n = 0; n < 2; ++n) sv[bj][n] = *(const GAS f32x4*)(scale + col0 + bj * HALF + 4 * n);
#pragma unroll
        for (int ai = 0; ai < 2; ++ai)
#pragma unroll
            for (int m = 0; m < 4; ++m) { const size_t off = (size_t)(row0 + ai * HALF + m * 16) * D + col0; float sq = 0.f;
#pragma unroll
                for (int bj = 0; bj < 2; ++bj) { const f32x4 x0 = __builtin_nontemporal_load((const GAS f32x4*)(X + off + bj * HALF)), x1 = __builtin_nontemporal_load((const GAS f32x4*)(X + off + bj * HALF + 4));
                    const f32x4 v0 = x0 + acc[ai][bj][m][0] * sv[bj][0], v1 = x1 + acc[ai][bj][m][1] * sv[bj][1];
                    const f32x4 q = v0 * v0 + v1 * v1; sq += (q[0] + q[1]) + (q[2] + q[3]);
                    *(GAS u32x4*)(Hh + off + bj * HALF) = (u32x4){cvt_pk_bf16(v0[0], v0[1]), cvt_pk_bf16(v0[2], v0[3]), cvt_pk_bf16(v1[0], v1[1]), cvt_pk_bf16(v1[2], v1[3])}; }
                ss[ai][m] = sq;
                asm volatile("" ::: "memory"); }
#pragma unroll
        for (int ai = 0; ai < 2; ++ai)
#pragma unroll
            for (int m = 0; m < 4; ++m) { float v = ss[ai][m]; v += __shfl_xor(v, 16); v += __shfl_xor(v, 32); if (fq == 0) red[(ai * HALF + wr * 64 + m * 16 + fr) * 4 + wc] = v; }
        __syncthreads();
        { const int t = (int)threadIdx.x; if (t < BM) { const f32x4 r4 = *(LAS f32x4*)(red + t * 4); part[(size_t)(u.pm * BM + t) * 8 + u.pn] = (r4[0] + r4[1]) + (r4[2] + r4[3]); } }
        __syncthreads();
    }
};
struct EpiResid {
    static constexpr bool PERM = true;
    bf16* Hh; float post = 1.0f;
    __device__ __forceinline__ void operator()(const f32x4 (&acc)[2][2][4][2], const Unit& u, int wr, int wc, int fr, int fq) const {
        const int row0 = u.pm * BM + wr * 64 + fr, col0 = u.pn * BM + wc * 32 + 8 * fq;
#pragma unroll
        for (int ai = 0; ai < 2; ++ai)
#pragma unroll
            for (int m = 0; m < 4; ++m) { GAS bf16* rowp = (GAS bf16*)Hh + (size_t)(row0 + ai * HALF + m * 16) * D + col0;
#pragma unroll
                for (int bj = 0; bj < 2; ++bj) { f32x4 h0, h1; unpk8(*(const GAS u32x4*)(rowp + bj * HALF), h0, h1);
                    const f32x4 v0 = h0 + acc[ai][bj][m][0] * post, v1 = h1 + acc[ai][bj][m][1] * post;
                    *(GAS u32x4*)(rowp + bj * HALF) = (u32x4){cvt_pk_bf16(v0[0], v0[1]), cvt_pk_bf16(v0[2], v0[3]), cvt_pk_bf16(v1[0], v1[1]), cvt_pk_bf16(v1[2], v1[3])}; }
                asm volatile("" ::: "memory"); }
    }
};
struct EpiSwiglu {
    static constexpr bool PERM = true;
    bf16* O; int ldo; const float* part;
    __device__ __forceinline__ void operator()(const f32x4 (&acc)[2][2][4][2], const Unit& u, int wr, int wc, int fr, int fq) const {
        const int row0 = u.pm * BM + wr * 64 + fr, col0 = u.pn * HALF + wc * 32 + 8 * fq;
#pragma unroll
        for (int ai = 0; ai < 2; ++ai)
#pragma unroll
            for (int m = 0; m < 4; ++m) {
                float rsv; { const GAS f32x4* pp = (const GAS f32x4*)(part + (size_t)(row0 + ai * HALF + m * 16) * 8); const f32x4 p0 = pp[0], p1 = pp[1]; rsv = 1.0f / sqrtf((((p0[0] + p0[1]) + (p0[2] + p0[3])) + ((p1[0] + p1[1]) + (p1[2] + p1[3]))) * (1.0f / D) + RMS_EPS); }
                float o[8];
#pragma unroll
                for (int n = 0; n < 2; ++n)
#pragma unroll
                    for (int j = 0; j < 4; ++j) { const float gt = acc[ai][0][m][n][j] * rsv, up = acc[ai][1][m][n][j] * rsv; o[4 * n + j] = gt * sigmoidf_(gt) * up; }
                u32x4 w; w.x = cvt_pk_bf16(o[0], o[1]); w.y = cvt_pk_bf16(o[2], o[3]); w.z = cvt_pk_bf16(o[4], o[5]); w.w = cvt_pk_bf16(o[6], o[7]);
                *(GAS u32x4*)(O + (size_t)(row0 + ai * HALF + m * 16) * ldo + col0) = w; }
    }
};
struct EpiSwigluF8 {
    static constexpr bool PERM = true;
    unsigned char* O; int ldo; float pre;
    __device__ __forceinline__ void operator()(const f32x4 (&acc)[2][2][4][2], const Unit& u, int wr, int wc, int fr, int fq) const {
        const int row0 = u.pm * BM + wr * 64 + fr, col0 = u.pn * HALF + wc * 32 + 8 * fq;
        const float c_e = -1.44269504f * pre, c_gu = pre * pre * F8_SH;
#pragma unroll
        for (int ai = 0; ai < 2; ++ai)
#pragma unroll
            for (int m = 0; m < 4; ++m) {
                float o[8];
#pragma unroll
                for (int n = 0; n < 2; ++n)
#pragma unroll
                    for (int j = 0; j < 4; ++j) { const float ga = acc[ai][0][m][n][j], ua = acc[ai][1][m][n][j];
                        const float sg = __builtin_amdgcn_rcpf(1.0f + __builtin_amdgcn_exp2f(ga * c_e));
                        o[4 * n + j] = __builtin_amdgcn_fmed3f(ga * sg * (ua * c_gu), -448.f, 448.f); }
                int w0 = 0, w1 = 0;
                w0 = __builtin_amdgcn_cvt_pk_fp8_f32(o[0], o[1], w0, false); w0 = __builtin_amdgcn_cvt_pk_fp8_f32(o[2], o[3], w0, true);
                w1 = __builtin_amdgcn_cvt_pk_fp8_f32(o[4], o[5], w1, false); w1 = __builtin_amdgcn_cvt_pk_fp8_f32(o[6], o[7], w1, true);
                *(GAS u32x2*)(O + (size_t)(row0 + ai * HALF + m * 16) * ldo + col0) = (u32x2){(unsigned)w0, (unsigned)w1}; }
    }
};
struct EpiSwigluF8R {
    static constexpr bool PERM = true;
    unsigned char* O; int ldo; float osc; const float* part;
    __device__ __forceinline__ void operator()(const f32x4 (&acc)[2][2][4][2], const Unit& u, int wr, int wc, int fr, int fq) const {
        const int row0 = u.pm * BM + wr * 64 + fr, col0 = u.pn * HALF + wc * 32 + 8 * fq;
#pragma unroll
        for (int ai = 0; ai < 2; ++ai)
#pragma unroll
            for (int m = 0; m < 4; ++m) {
                float rsv; { const GAS f32x4* pp = (const GAS f32x4*)(part + (size_t)(row0 + ai * HALF + m * 16) * 8); const f32x4 p0 = pp[0], p1 = pp[1]; rsv = 1.0f / sqrtf((((p0[0] + p0[1]) + (p0[2] + p0[3])) + ((p1[0] + p1[1]) + (p1[2] + p1[3]))) * (1.0f / D) + RMS_EPS); }
                const float c_e = -1.44269504f * rsv, c_gu = rsv * rsv * osc;
                float o[8];
#pragma unroll
                for (int n = 0; n < 2; ++n)
#pragma unroll
                    for (int j = 0; j < 4; ++j) { const float ga = acc[ai][0][m][n][j], ua = acc[ai][1][m][n][j];
                        const float sg = __builtin_amdgcn_rcpf(1.0f + __builtin_amdgcn_exp2f(ga * c_e));
                        o[4 * n + j] = __builtin_amdgcn_fmed3f(ga * sg * (ua * c_gu), -448.f, 448.f); }
                int w0 = 0, w1 = 0;
                w0 = __builtin_amdgcn_cvt_pk_fp8_f32(o[0], o[1], w0, false); w0 = __builtin_amdgcn_cvt_pk_fp8_f32(o[2], o[3], w0, true);
                w1 = __builtin_amdgcn_cvt_pk_fp8_f32(o[4], o[5], w1, false); w1 = __builtin_amdgcn_cvt_pk_fp8_f32(o[6], o[7], w1, true);
                *(GAS u32x2*)(O + (size_t)(row0 + ai * HALF + m * 16) * ldo + col0) = (u32x2){(unsigned)w0, (unsigned)w1}; }
    }
};
struct EpiRkvLo {
    static constexpr bool PERM = true;
    bf16* RKV; bf16* LO;
    __device__ __forceinline__ void operator()(const f32x4 (&acc)[2][2][4][2], const Unit& u, int wr, int wc, int fr, int fq) const {
        const int row0 = u.pm * BM + wr * 64 + fr; const int aux = u.aux;
        bf16* base; int ldo;
        if (aux < 3) { base = RKV + (size_t)aux * M * D + u.pn * BM; ldo = D; } else { base = LO + (size_t)(aux - 3) * M * 256; ldo = 256; }
        base += wc * 32 + 8 * fq;
#pragma unroll
        for (int ai = 0; ai < 2; ++ai)
#pragma unroll
            for (int m = 0; m < 4; ++m) { bf16* rowp = base + (size_t)(row0 + ai * HALF + m * 16) * ldo;
#pragma unroll
                for (int bj = 0; bj < 2; ++bj) { f32x4 v0 = acc[ai][bj][m][0], v1 = acc[ai][bj][m][1];
                    if (aux == 3) {
#pragma unroll
                        for (int j = 0; j < 4; ++j) { v0[j] = 1.0f - 2.0f * __builtin_amdgcn_rcpf(1.0f + __expf(2.0f * v0[j])); v1[j] = 1.0f - 2.0f * __builtin_amdgcn_rcpf(1.0f + __expf(2.0f * v1[j])); } }
                    else if (aux == 5) {
#pragma unroll
                        for (int j = 0; j < 4; ++j) { v0[j] = sigmoidf_(v0[j]); v1[j] = sigmoidf_(v1[j]); } }
                    u32x4 w; w.x = cvt_pk_bf16(v0[0], v0[1]); w.y = cvt_pk_bf16(v0[2], v0[3]); w.z = cvt_pk_bf16(v1[0], v1[1]); w.w = cvt_pk_bf16(v1[2], v1[3]);
                    *(GAS u32x4*)(rowp + bj * HALF) = w; } }
    }
};
struct EpiMoeDown {
    static constexpr bool PERM = true;
    const i32x2* meta; bf16* Y; bf16* P2; float post;
    __device__ __forceinline__ void operator()(const f32x4 (&acc)[2][2][4][2], const Unit& u, int wr, int wc, int fr, int fq) const {
        const int row0 = u.pm * BM + wr * 64 + fr, col0 = u.pn * BM + wc * 32 + 8 * fq;
#pragma unroll
        for (int ai = 0; ai < 2; ++ai)
#pragma unroll
            for (int m = 0; m < 4; ++m) { const i32x2 mt = *(const GAS i32x2*)(meta + row0 + ai * HALF + m * 16);
                if (mt.x >= 0) { const int tok = mt.x & 0x3fff, slot = (mt.x >> 14) & 1; const float gt = __int_as_float(mt.y) * post;
                    GAS bf16* rowp = (u.aux == 0) ? (GAS bf16*)Y + ((size_t)slot * M + tok) * D + col0 : (GAS bf16*)P2 + ((size_t)(u.aux - 1) * 2048 + (row0 + ai * HALF + m * 16 - 32768)) * D + col0;
#pragma unroll
                    for (int bj = 0; bj < 2; ++bj) { const f32x4 v0 = acc[ai][bj][m][0] * gt, v1 = acc[ai][bj][m][1] * gt;
                        *(GAS u32x4*)(rowp + bj * HALF) = (u32x4){cvt_pk_bf16(v0[0], v0[1]), cvt_pk_bf16(v0[2], v0[3]), cvt_pk_bf16(v1[0], v1[1]), cvt_pk_bf16(v1[2], v1[3])}; } } }
    }
};
}

#define XB_TMO      128
#define XB_XCNT(j)  (256  + 64 * (j))
#define XB_XSUB(j)  (1280 + 64 * (j))
#define XB_XGEN(j)  (2304 + 64 * (j))
#define XB_TOP      3328
#define XB_TOPGEN   3392
#define XCD_BAR_WORDS 3456
#define XB_SPIN_CAP (1u << 18)
__device__ __forceinline__ unsigned xb_ld(unsigned* p)              { return __hip_atomic_load(p, __ATOMIC_RELAXED, __HIP_MEMORY_SCOPE_AGENT); }
__device__ __forceinline__ unsigned xb_add(unsigned* p, unsigned v) { return __hip_atomic_fetch_add(p, v, __ATOMIC_RELAXED, __HIP_MEMORY_SCOPE_AGENT); }
__device__ __forceinline__ unsigned xb_xcc_id() { return (unsigned)__builtin_amdgcn_s_getreg((3 << 11) | 20) & 0xFu; }
#define XB_SPIN(cond, bar) do { unsigned _sp = 0; while (cond) { __builtin_amdgcn_s_sleep(1); \
    if ((++_sp & 255u) == 0u) { if (xb_ld(&(bar)[XB_TMO])) break; if (_sp > XB_SPIN_CAP) { atomicAdd(&(bar)[XB_TMO], 1u); break; } } } } while (0)
struct XcdBarrier { unsigned* bar; unsigned x; volatile LAS unsigned* st; };
__device__ __forceinline__ XcdBarrier xcd_barrier_post(unsigned* bar, volatile LAS unsigned* st) {
    XcdBarrier b; b.bar = bar; b.x = xb_xcc_id(); b.st = st;
    if (threadIdx.x == 0) (void)xb_add(&bar[XB_XCNT(b.x)], 1u);
    return b;
}
__device__ __forceinline__ void xcd_barrier_complete(unsigned* bar, unsigned x, unsigned& nloc, unsigned& nx) {
    const unsigned G = gridDim.x * gridDim.y * gridDim.z;
    unsigned sum, cnt, mine, sp = 0u;
    for (;;) {
        sum = 0u; cnt = 0u; mine = 0u;
#pragma unroll
        for (unsigned j = 0; j < 16; ++j) { const unsigned c = xb_ld(&bar[XB_XCNT(j)]); sum += c; cnt += (c > 0u) ? 1u : 0u; mine = (j == x) ? c : mine; }
        if (sum == G) break;
        __builtin_amdgcn_s_sleep(1);
        if ((++sp & 255u) == 0u) { if (xb_ld(&bar[XB_TMO])) break; if (sp > XB_SPIN_CAP) { atomicAdd(&bar[XB_TMO], 1u); break; } }
    }
    nloc = mine > 0u ? mine : 1u; nx = cnt > 0u ? cnt : 1u;
}
__device__ __forceinline__ void xcd_barrier(const XcdBarrier& b) {
    asm volatile("s_waitcnt vmcnt(0)" ::: "memory");
    __syncthreads();
    if (threadIdx.x == 0) {
        unsigned* bar = b.bar;
        __builtin_amdgcn_s_waitcnt(0);
        unsigned nloc = b.st[0], nx = b.st[1];
        if (nloc == 0u) { xcd_barrier_complete(bar, b.x, nloc, nx); b.st[0] = nloc; b.st[1] = nx; }
        const unsigned old = xb_add(&bar[XB_XSUB(b.x)], 1u);
        const unsigned gen = old / nloc;
        if (old + 1u == (gen + 1u) * nloc) {
            __builtin_amdgcn_fence(__ATOMIC_RELEASE, "agent");
            asm volatile("s_waitcnt vmcnt(0)" ::: "memory");
            const unsigned og = xb_add(&bar[XB_TOP], 1u);
            const unsigned tg = og / nx;
            if (og + 1u == (tg + 1u) * nx) xb_add(&bar[XB_TOPGEN], 1u);
            else XB_SPIN(xb_ld(&bar[XB_TOPGEN]) == tg, bar);
            __builtin_amdgcn_fence(__ATOMIC_ACQUIRE, "agent");
            xb_add(&bar[XB_XGEN(b.x)], 1u);
            asm volatile("s_waitcnt vmcnt(0)" ::: "memory");
        } else {
            XB_SPIN(xb_ld(&bar[XB_XGEN(b.x)]) == gen, bar);
            __builtin_amdgcn_fence(__ATOMIC_ACQUIRE, "agent");
            asm volatile("s_waitcnt vmcnt(0)" ::: "memory");
        }
    }
    __syncthreads();
}

struct SchedPlain {
    pg8::TileOrder T; unsigned long long astep, bstep;
    __device__ __forceinline__ bool next(int i, pg8::Unit& u) const { int pm, pn; if (!T.map(i, pm, pn)) return false; u.pm = pm; u.pn = pn; u.aux = 0; u.aoff = (unsigned long long)pm * astep; u.boff = (unsigned long long)pn * bstep; return true; }
};
struct SchedPool {
    pg8::TileOrder T;
    __device__ __forceinline__ bool next(int i, pg8::Unit& u) const { int pm, pn; if (!T.map(i, pm, pn)) return false; u.pm = pm; u.pn = pn; u.aux = 0;
        u.aoff = (unsigned long long)pm * 256 * D * 2 + (unsigned long long)(pn >> 1) * 512 * 2; u.boff = (unsigned long long)pn * 256 * 512 * 2; return true; }
};
struct SchedRkvLo {
    pg8::TileOrder T;
    __device__ __forceinline__ bool next(int i, pg8::Unit& u) const { int pm, pn; if (!T.map(i, pm, pn)) return false; u.pm = pm;
        int amat;
        if (pn < 24) { const int w = pn >> 3; u.aux = w; u.pn = pn & 7; amat = (w == 0) ? 0 : (w == 1 ? 2 : 3); }
        else { const int q = pn - 24; u.aux = 3 + q; u.pn = 0; amat = (q == 0) ? 1 : (q == 1 ? 4 : 5); }
        u.aoff = ((unsigned long long)amat * M + (unsigned long long)pm * 256) * D * 2; u.boff = (unsigned long long)pn * 256 * D * 2; return true; }
};
struct SchedMoe {
    pg8::TileOrder T; const LAS unsigned* tile_e; unsigned long long astep, bstep; int nN;
    __device__ __forceinline__ bool next(int i, pg8::Unit& u) const { int pm, pn; if (!T.map(i, pm, pn)) return false; u.pm = pm; u.pn = pn; u.aux = 0;
        const int e = (int)__builtin_amdgcn_readfirstlane(tile_e[pm]) & 7;
        u.aoff = (unsigned long long)pm * astep; u.boff = (unsigned long long)(e * nN + pn) * bstep; return true; }
};

constexpr int REP3 = 1, REP6 = 1, REP7 = 1, REP8 = 1, REP9 = 1, REP11 = 1, REP13 = 1, REP14 = 1, REP0 = 1, REP2 = 1, REP5 = 1, REP12 = 1, REP15 = 1;
struct SchedMoeTail {
    int nq, G, c; const LAS unsigned* tile_e;
    __device__ __forceinline__ bool next(int i, pg8::Unit& u) const { const int L = i * G + c; if (L >= nq) return false; const int kq = L & 3, uu = L >> 2, pm = 128 + (uu >> 3), pn = uu & 7;
        const int e = (int)__builtin_amdgcn_readfirstlane(tile_e[pm]) & 7;
        u.pm = pm; u.pn = pn; u.aux = kq; u.aoff = (unsigned long long)pm * 256 * FFE + (unsigned long long)kq * KQ; u.boff = (unsigned long long)(e * 8 + pn) * 256 * FFE + (unsigned long long)kq * KQ; return true; }
};
struct Params { const float* in[33]; float* out; unsigned char* ws; int ph_lo, ph_hi; };

template <bool NTS = false>
__device__ __forceinline__ void tr_tile(const float* W, int N, int k0, int n0, bf16* WT, size_t drow0, int ldd, LAS float* scr, int lane, const float* kscale = nullptr) {
    const int kq = lane >> 4, n4 = (lane & 15) * 4;
    f32x4 v[16];
#pragma unroll
    for (int i = 0; i < 16; ++i) v[i] = __builtin_nontemporal_load((const GAS f32x4*)(W + (size_t)(k0 + 4 * i + kq) * N + n0 + n4));
    if (kscale) {
#pragma unroll
        for (int i = 0; i < 16; ++i) v[i] = v[i] * kscale[k0 + 4 * i + kq]; }
#pragma unroll
    for (int i = 0; i < 16; ++i) { LAS float* s = scr + (4 * i + kq) * 65 + n4; s[0] = v[i].x; s[1] = v[i].y; s[2] = v[i].z; s[3] = v[i].w; }
    LDS_WAIT(); asm volatile("" ::: "memory");
    const int c = lane & 7;
#pragma unroll
    for (int p = 0; p < 8; ++p) { const int n = (lane >> 3) + 8 * p; const LAS float* s = scr + (8 * c) * 65 + n;
        u32x4 o; o.x = cvt_pk_bf16(s[0], s[65]); o.y = cvt_pk_bf16(s[2 * 65], s[3 * 65]); o.z = cvt_pk_bf16(s[4 * 65], s[5 * 65]); o.w = cvt_pk_bf16(s[6 * 65], s[7 * 65]);
        if (NTS) __builtin_nontemporal_store(o, (GAS u32x4*)(WT + (drow0 + n) * ldd + k0 + 8 * c)); else *(GAS u32x4*)(WT + (drow0 + n) * ldd + k0 + 8 * c) = o; }
    LDS_WAIT(); asm volatile("" ::: "memory");
}
__device__ __forceinline__ void cv8_load(const float* W, int N, int k0, int n0, f32x4 (&v)[16], int lane) {
    const int kq = lane >> 4, n4 = (lane & 15) * 4;
#pragma unroll
    for (int i = 0; i < 16; ++i) v[i] = __builtin_nontemporal_load((const GAS f32x4*)(W + (size_t)(k0 + 16 * kq + i) * N + n0 + n4));
}
__device__ __forceinline__ void cv8_store(const f32x4 (&v)[16], int k0, unsigned char* WT, size_t drow0, int ldd, float sc, int lane) {
    const int kq = lane >> 4, n4 = (lane & 15) * 4;
#pragma unroll
    for (int e = 0; e < 4; ++e) { u32x4 o;
#pragma unroll
        for (int d = 0; d < 4; ++d) { int w = 0;
            w = __builtin_amdgcn_cvt_pk_fp8_f32(__builtin_amdgcn_fmed3f(v[4 * d][e] * sc, -448.f, 448.f), __builtin_amdgcn_fmed3f(v[4 * d + 1][e] * sc, -448.f, 448.f), w, false);
            w = __builtin_amdgcn_cvt_pk_fp8_f32(__builtin_amdgcn_fmed3f(v[4 * d + 2][e] * sc, -448.f, 448.f), __builtin_amdgcn_fmed3f(v[4 * d + 3][e] * sc, -448.f, 448.f), w, true);
            o[d] = (unsigned)w; }
        __builtin_nontemporal_store(o, (GAS u32x4*)(WT + (drow0 + n4 + e) * ldd + k0 + 16 * kq)); }
}
constexpr int MOE_T_E = 32 * 112, MOE_NT = NE * 3 * MOE_T_E;
__device__ __forceinline__ void moe_cvh_load(const float* const* in, int it, int h, f32x2 (&v)[16], int lane) {
    const int e = it / (3 * MOE_T_E), r3 = it % (3 * MOE_T_E), which = r3 / MOE_T_E, t = r3 % MOE_T_E;
    const int kq = lane >> 4, n2 = (lane & 15) * 2 + 32 * h;
    const float* W; int N, k0, n0;
    if (which < 2) { W = in[29 + which] + (size_t)e * D * FFE; N = FFE; k0 = 64 * (t / 112); n0 = 64 * (t % 112); } else { W = in[31] + (size_t)e * FFE * D; N = D; k0 = 64 * (t / 32); n0 = 64 * (t % 32); }
#pragma unroll
    for (int i = 0; i < 16; ++i) v[i] = __builtin_nontemporal_load((const GAS f32x2*)(W + (size_t)(k0 + 16 * kq + i) * N + n0 + n2));
}
__device__ __forceinline__ void moe_cvh_store(unsigned char* ws, int it, int h, const f32x2 (&v)[16], int lane) {
    const int e = it / (3 * MOE_T_E), r3 = it % (3 * MOE_T_E), which = r3 / MOE_T_E, t = r3 % MOE_T_E;
    const int kq = lane >> 4, n2 = (lane & 15) * 2 + 32 * h;
    unsigned char* WT; size_t drow0; int ldd, k0; float sc;
    if (which < 2) { const int nb2 = t % 112; WT = ws + WS_WGUT; drow0 = (size_t)e * 2 * FFE + (size_t)((64 * nb2) >> 7) * 256 + 128 * which + ((64 * nb2) & 127); ldd = D; k0 = 64 * (t / 112); sc = F8_SWU; }
    else { WT = ws + WS_WDT; drow0 = (size_t)e * D + 64 * (t % 32); ldd = FFE; k0 = 64 * (t / 32); sc = F8_SWD; }
#pragma unroll
    for (int e2 = 0; e2 < 2; ++e2) { u32x4 o;
#pragma unroll
        for (int d = 0; d < 4; ++d) { int w = 0;
            w = __builtin_amdgcn_cvt_pk_fp8_f32(__builtin_amdgcn_fmed3f(v[4 * d][e2] * sc, -448.f, 448.f), __builtin_amdgcn_fmed3f(v[4 * d + 1][e2] * sc, -448.f, 448.f), w, false);
            w = __builtin_amdgcn_cvt_pk_fp8_f32(__builtin_amdgcn_fmed3f(v[4 * d + 2][e2] * sc, -448.f, 448.f), __builtin_amdgcn_fmed3f(v[4 * d + 3][e2] * sc, -448.f, 448.f), w, true);
            o[d] = (unsigned)w; }
        __builtin_nontemporal_store(o, (GAS u32x4*)(WT + (drow0 + n2 + e2) * ldd + k0 + 16 * kq)); }
}
constexpr int CVW0 = 4, NCW = 8 - CVW0, MOE_CV_EARLY = (SEQ / 64) * NCW * 256;
constexpr int MOE_CV_HALVES = 2 * (MOE_NT - MOE_CV_EARLY);
static_assert(MOE_CV_HALVES <= (SEQ / 64) * 3 * 256, "half-item slots");
static_assert(MOE_CV_EARLY <= MOE_NT && 2 * BATCH * NH == 256, "early weight-copy items are indexed by the 256 scan workgroups");
__device__ __forceinline__ void moe_cv_load(const float* const* in, int it, f32x4 (&v)[16], int lane) {
    const int e = it / (3 * MOE_T_E), r3 = it % (3 * MOE_T_E), which = r3 / MOE_T_E, t = r3 % MOE_T_E;
    if (which < 2) cv8_load(in[29 + which] + (size_t)e * D * FFE, FFE, 64 * (t / 112), 64 * (t % 112), v, lane);
    else cv8_load(in[31] + (size_t)e * FFE * D, D, 64 * (t / 32), 64 * (t % 32), v, lane);
}
__device__ __forceinline__ void moe_cv_store(unsigned char* ws, int it, const f32x4 (&v)[16], int lane) {
    const int e = it / (3 * MOE_T_E), r3 = it % (3 * MOE_T_E), which = r3 / MOE_T_E, t = r3 % MOE_T_E;
    if (which < 2) { const int nb2 = t % 112; cv8_store(v, 64 * (t / 112), ws + WS_WGUT, (size_t)e * 2 * FFE + (size_t)((64 * nb2) >> 7) * 256 + 128 * which + ((64 * nb2) & 127), D, F8_SWU, lane); }
    else cv8_store(v, 64 * (t / 32), ws + WS_WDT, (size_t)e * D + 64 * (t % 32), FFE, F8_SWD, lane);
}
__device__ __forceinline__ void tr_f8_load(const float* W, int N, int k0, int n0, f32x4 (&v)[16], int lane) {
    const int kq = lane >> 4, n4 = (lane & 15) * 4;
#pragma unroll
    for (int i = 0; i < 16; ++i) v[i] = __builtin_nontemporal_load((const GAS f32x4*)(W + (size_t)(k0 + 4 * i + kq) * N + n0 + n4));
}
__device__ __forceinline__ void tr_f8_store(const f32x4 (&v)[16], int k0, unsigned char* WT, size_t drow0, int ldd, float sc, LAS float* scr, int lane) {
    const int kq = lane >> 4, n4 = (lane & 15) * 4;
#pragma unroll
    for (int i = 0; i < 16; ++i) { LAS float* s = scr + (4 * i + kq) * 65 + n4; s[0] = v[i].x; s[1] = v[i].y; s[2] = v[i].z; s[3] = v[i].w; }
    LDS_WAIT(); asm volatile("" ::: "memory");
    const int c = lane & 3;
#pragma unroll
    for (int p = 0; p < 4; ++p) { const int n = (lane >> 2) + 16 * p; const LAS float* s = scr + (16 * c) * 65 + n;
        u32x4 o;
#pragma unroll
        for (int d = 0; d < 4; ++d) o[d] = pk4_fp8(s[(4 * d) * 65] * sc, s[(4 * d + 1) * 65] * sc, s[(4 * d + 2) * 65] * sc, s[(4 * d + 3) * 65] * sc);
        __builtin_nontemporal_store(o, (GAS u32x4*)(WT + (drow0 + n) * ldd + k0 + 16 * c)); }
    LDS_WAIT(); asm volatile("" ::: "memory");
}
__device__ __forceinline__ void tr_tile32(const float* W, int N, int k0, int n0, bf16* WT, size_t drow0, int ldd, LAS float* scr, int lane) {
    float v[16];
#pragma unroll
    for (int i = 0; i < 16; ++i) v[i] = W[(size_t)(k0 + 2 * i + (lane >> 5)) * N + n0 + (lane & 31)];
#pragma unroll
    for (int i = 0; i < 16; ++i) scr[(2 * i + (lane >> 5)) * 33 + (lane & 31)] = v[i];
    LDS_WAIT(); asm volatile("" ::: "memory");
    const int n = lane & 31, hf = lane >> 5; const LAS float* s = scr + (16 * hf) * 33 + n;
    u32x4 o0, o1;
#pragma unroll
    for (int d = 0; d < 4; ++d) { o0[d] = cvt_pk_bf16(s[(2 * d) * 33], s[(2 * d + 1) * 33]); o1[d] = cvt_pk_bf16(s[(8 + 2 * d) * 33], s[(9 + 2 * d) * 33]); }
    GAS u32x4* dst = (GAS u32x4*)(WT + (drow0 + n) * ldd + k0 + 16 * hf); dst[0] = o0; dst[1] = o1;
    LDS_WAIT(); asm volatile("" ::: "memory");
}

__device__ __forceinline__ float row_sumsq(const float* xr, int lane) {
    const GAS f32x4* p = (const GAS f32x4*)xr + lane; float s = 0.f;
#pragma unroll
    for (int j = 0; j < 8; ++j) { const f32x4 v = p[64 * j]; s += (v.x * v.x + v.y * v.y) + (v.z * v.z + v.w * v.w); }
    return wave_sum(s);
}
__device__ __forceinline__ float row_sumsq_b(const bf16* xr, int lane) {
    float s = 0.f;
#pragma unroll
    for (int j = 0; j < 4; ++j) { f32x4 a, c; unpk8(*(const GAS u32x4*)(xr + 8 * lane + 512 * j), a, c); s += ((a.x * a.x + a.y * a.y) + (a.z * a.z + a.w * a.w)) + ((c.x * c.x + c.y * c.y) + (c.z * c.z + c.w * c.w)); }
    return wave_sum(s);
}
__device__ __forceinline__ float rstd_of(float ss) { return 1.0f / sqrtf(ss * (1.0f / D) + RMS_EPS); }

__device__ __forceinline__ void rms_row_bf16(const float* xr, const float* gamma, bf16* orow, int lane) {
    f32x4 v[8]; float s = 0.f;
#pragma unroll
    for (int j = 0; j < 4; ++j) { v[2 * j] = __builtin_nontemporal_load((const GAS f32x4*)(xr + 8 * lane + 512 * j)); v[2 * j + 1] = __builtin_nontemporal_load((const GAS f32x4*)(xr + 8 * lane + 512 * j + 4)); }
#pragma unroll
    for (int j = 0; j < 8; ++j) s += (v[j].x * v[j].x + v[j].y * v[j].y) + (v[j].z * v[j].z + v[j].w * v[j].w);
    const float rs = rstd_of(wave_sum(s));
#pragma unroll
    for (int j = 0; j < 4; ++j) { const f32x4 g0 = *(const GAS f32x4*)(gamma + 8 * lane + 512 * j), g1 = *(const GAS f32x4*)(gamma + 8 * lane + 512 * j + 4);
        const f32x4 a = v[2 * j] * rs * g0, c = v[2 * j + 1] * rs * g1;
        *(GAS u32x4*)(orow + 8 * lane + 512 * j) = (u32x4){cvt_pk_bf16(a.x, a.y), cvt_pk_bf16(a.z, a.w), cvt_pk_bf16(c.x, c.y), cvt_pk_bf16(c.z, c.w)}; }
}

__device__ __forceinline__ void rms_row_bf16_b(const bf16* xr, const float* gamma, bf16* orow, int lane) {
    f32x4 v[8]; float s = 0.f;
#pragma unroll
    for (int j = 0; j < 4; ++j) unpk8(__builtin_nontemporal_load((const GAS u32x4*)(xr + 8 * lane + 512 * j)), v[2 * j], v[2 * j + 1]);
#pragma unroll
    for (int j = 0; j < 8; ++j) s += (v[j].x * v[j].x + v[j].y * v[j].y) + (v[j].z * v[j].z + v[j].w * v[j].w);
    const float rs = rstd_of(wave_sum(s));
#pragma unroll
    for (int j = 0; j < 4; ++j) { const f32x4 g0 = *(const GAS f32x4*)(gamma + 8 * lane + 512 * j), g1 = *(const GAS f32x4*)(gamma + 8 * lane + 512 * j + 4);
        const f32x4 a = v[2 * j] * rs * g0, c = v[2 * j + 1] * rs * g1;
        *(GAS u32x4*)(orow + 8 * lane + 512 * j) = (u32x4){cvt_pk_bf16(a.x, a.y), cvt_pk_bf16(a.z, a.w), cvt_pk_bf16(c.x, c.y), cvt_pk_bf16(c.z, c.w)}; }
}

template <int MODE>
__device__ __forceinline__ void lora_up_item(const bf16* A, int lda, const bf16* Bt, const float* bias, bf16* out, int m0, int n0, int lane, LAS unsigned char* stg) {
    constexpr int KS = 6;
    const int r = lane & 31, hh = lane >> 5;
    bf16x8 af[KS];
#pragma unroll
    for (int s = 0; s < KS; ++s) af[s] = *(const GAS bf16x8*)(A + (size_t)(m0 + r) * lda + 16 * s + 8 * hh);
    bf16x8 bcur[KS]; f32x4 bvc[4];
#pragma unroll
    for (int s = 0; s < KS; ++s) bcur[s] = *(const GAS bf16x8*)(Bt + (size_t)(n0 + r) * (16 * KS) + 16 * s + 8 * hh);
#pragma unroll
    for (int g4 = 0; g4 < 4; ++g4) bvc[g4] = *(const GAS f32x4*)(bias + n0 + 8 * g4 + 4 * hh);
    for (int ct = 0; ct < 16; ++ct) {
        const int nb = n0 + 32 * ct, nn = n0 + 32 * ((ct < 15) ? ct + 1 : ct);
        bf16x8 bnx[KS]; f32x4 bvn[4];
#pragma unroll
        for (int s = 0; s < KS; ++s) bnx[s] = *(const GAS bf16x8*)(Bt + (size_t)(nn + r) * (16 * KS) + 16 * s + 8 * hh);
#pragma unroll
        for (int g4 = 0; g4 < 4; ++g4) bvn[g4] = *(const GAS f32x4*)(bias + nn + 8 * g4 + 4 * hh);
        f32x16 acc;
#pragma unroll
        for (int i = 0; i < 16; ++i) acc[i] = 0.f;
#pragma unroll
        for (int s = 0; s < KS; ++s) acc = __builtin_amdgcn_mfma_f32_32x32x16_bf16(bcur[s], af[s], acc, 0, 0, 0);
#pragma unroll
        for (int g4 = 0; g4 < 4; ++g4) { f32x4 v = (f32x4){acc[4 * g4], acc[4 * g4 + 1], acc[4 * g4 + 2], acc[4 * g4 + 3]} + bvc[g4];
#pragma unroll
            for (int j = 0; j < 4; ++j) v[j] = sigmoidf_(v[j]) * (MODE == 0 ? 0.60653066f : 1.0f);
            *(LAS u32x2*)(stg + r * 144 + ((ct & 1) * 32 + 8 * g4 + 4 * hh) * 2) = (u32x2){cvt_pk_bf16(v[0], v[1]), cvt_pk_bf16(v[2], v[3])}; }
        if (ct & 1) {
            LDS_WAIT(); asm volatile("" ::: "memory");
#pragma unroll
            for (int ps = 0; ps < 4; ++ps) { const int row = (lane >> 3) + 8 * ps, ch = lane & 7;
                const u32x4 w = *(const LAS u32x4*)(stg + row * 144 + ch * 16);
                __builtin_nontemporal_store(w, (GAS u32x4*)(out + (size_t)(m0 + row) * D + nb - 32 + 8 * ch)); }
            LDS_WAIT(); asm volatile("" ::: "memory"); }
#pragma unroll
        for (int s = 0; s < KS; ++s) bcur[s] = bnx[s];
#pragma unroll
        for (int g4 = 0; g4 < 4; ++g4) bvc[g4] = bvn[g4];
    }
}

__device__ __forceinline__ void lora_up_item_k256(const bf16* A, const bf16* Bt, bf16* out, int m0, int n0, int lane, LAS unsigned char* stg) {
    const int r = lane & 31, hh = lane >> 5;
    bf16x8 af[16];
#pragma unroll
    for (int s = 0; s < 16; ++s) af[s] = *(const GAS bf16x8*)(A + (size_t)(m0 + r) * 256 + 16 * s + 8 * hh);
    bf16x8 bcur[8];
#pragma unroll
    for (int s = 0; s < 8; ++s) bcur[s] = *(const GAS bf16x8*)(Bt + (size_t)(n0 + r) * 256 + 16 * s + 8 * hh);
    f32x16 acc;
    for (int hs = 0; hs < 32; ++hs) {
        const int ct = hs >> 1, kh = hs & 1, nb = n0 + 32 * ct;
        const int hn = (hs < 31) ? hs + 1 : hs; const int nn = n0 + 32 * (hn >> 1), kn = hn & 1;
        bf16x8 bnx[8];
#pragma unroll
        for (int s = 0; s < 8; ++s) bnx[s] = *(const GAS bf16x8*)(Bt + (size_t)(nn + r) * 256 + 128 * kn + 16 * s + 8 * hh);
        if (kh == 0) {
#pragma unroll
            for (int i = 0; i < 16; ++i) acc[i] = 0.f;
#pragma unroll
            for (int s = 0; s < 8; ++s) acc = __builtin_amdgcn_mfma_f32_32x32x16_bf16(bcur[s], af[s], acc, 0, 0, 0);
        } else {
#pragma unroll
            for (int s = 0; s < 8; ++s) acc = __builtin_amdgcn_mfma_f32_32x32x16_bf16(bcur[s], af[8 + s], acc, 0, 0, 0);
#pragma unroll
            for (int g4 = 0; g4 < 4; ++g4)
                *(LAS u32x2*)(stg + r * 144 + ((ct & 1) * 32 + 8 * g4 + 4 * hh) * 2) = (u32x2){cvt_pk_bf16(acc[4 * g4], acc[4 * g4 + 1]), cvt_pk_bf16(acc[4 * g4 + 2], acc[4 * g4 + 3])};
            if (ct & 1) {
                LDS_WAIT(); asm volatile("" ::: "memory");
#pragma unroll
                for (int ps = 0; ps < 4; ++ps) { const int row = (lane >> 3) + 8 * ps, ch = lane & 7;
                    const u32x4 w = *(const LAS u32x4*)(stg + row * 144 + ch * 16);
                    __builtin_nontemporal_store(w, (GAS u32x4*)(out + (size_t)(m0 + row) * D + nb - 32 + 8 * ch)); }
                LDS_WAIT(); asm volatile("" ::: "memory"); }
        }
#pragma unroll
        for (int s = 0; s < 8; ++s) bcur[s] = bnx[s];
    }
}

__global__ void __launch_bounds__(512, 2) fwd_kernel(Params p) {
    extern __shared__ __attribute__((aligned(16))) unsigned char lds_raw[];
    LAS unsigned char* lds = (LAS unsigned char*)lds_raw;
    volatile LAS unsigned* MISC = (volatile LAS unsigned*)(lds + MISC_OFF);
    const int tid = threadIdx.x, lane = tid & 63, wave = __builtin_amdgcn_readfirstlane(tid >> 6);
    const int G = gridDim.x, bid = blockIdx.x;
    const int gw = bid * 8 + wave, NGW = G * 8;
    unsigned char* ws = p.ws;
    if (tid < 64) MISC[tid] = 0u;
    __syncthreads();
    const XcdBarrier bar = xcd_barrier_post((unsigned*)(ws + WS_CTL) + 4096, MISC);
    const int lo = p.ph_lo, hi = p.ph_hi;
#define IN(k) (lo <= (k) && (k) < hi)
#define SEAM(k) do { if (IN(k) && IN((k) + 1)) xcd_barrier(bar); } while (0)

    const float* x = p.in[0];
    bf16* Hh = (bf16*)(ws + WS_H);

    if (IN(0)) for (int rep_ = 0; rep_ < REP0; ++rep_) {
        LAS float* scr = (LAS float*)lds + wave * (64 * 65);
        constexpr int T_POOL = 4 * 64, T_FFN = 32 * 88, T_SQ = 32 * 32, T_G1 = 32 * 4;
        constexpr int NT0 = T_POOL + 3 * T_FFN + 4 * T_SQ + T_G1;
        for (int it = gw; it < NT0; it += NGW) {
            int r = it; const float* W; int N, kb, nb; bf16* WT; size_t drow; int ldd; const float* ksc = nullptr;
            if (r < T_POOL) { const int g = r >> 6, t = r & 63; W = p.in[2] + (size_t)g * 512 * 512; N = 512; kb = t >> 3; nb = t & 7; WT = (bf16*)(ws + WS_POOLT); drow = (size_t)g * 512 + 64 * nb; ldd = 512; }
            else if ((r -= T_POOL) < T_FFN) { W = p.in[5]; N = FF0; kb = r / 88; nb = r % 88; WT = (bf16*)(ws + WS_FFN1T); drow = (size_t)((64 * nb) >> 7) * 256 + ((64 * nb) & 127); ldd = D; ksc = p.in[4]; }
            else if ((r -= T_FFN) < T_FFN) { W = p.in[6]; N = FF0; kb = r / 88; nb = r % 88; WT = (bf16*)(ws + WS_FFN1T); drow = (size_t)((64 * nb) >> 7) * 256 + 128 + ((64 * nb) & 127); ldd = D; ksc = p.in[4]; }
            else if ((r -= T_FFN) < T_FFN) {
                if constexpr (FFN_DOWN_FP8) { f32x4 v8[16]; cv8_load(p.in[7], D, 64 * (r / 32), 64 * (r % 32), v8, lane); cv8_store(v8, 64 * (r / 32), ws + WS_FFN2T, (size_t)64 * (r % 32), FF0, F8_SWD0, lane); continue; }
                else { W = p.in[7]; N = D; kb = r / 32; nb = r % 32; WT = (bf16*)(ws + WS_FFN2T); drow = 64 * nb; ldd = FF0; } }
            else if ((r -= T_FFN) < 3 * T_SQ) { const int w = r / T_SQ, t = r % T_SQ; W = p.in[10 + w]; N = D; kb = t / 32; nb = t % 32; WT = (bf16*)(ws + WS_RKVLOT); drow = (size_t)w * D + 64 * nb; ldd = D; }
            else if ((r -= 3 * T_SQ) < T_SQ) { W = p.in[13]; N = D; kb = r / 32; nb = r % 32; WT = (bf16*)(ws + WS_WOT); drow = 64 * nb; ldd = D; }
            else { r -= T_SQ; W = p.in[20]; N = LOG; kb = r / 4; nb = r % 4; WT = (bf16*)(ws + WS_RKVLOT); drow = (size_t)6656 + 64 * nb; ldd = D; }
            tr_tile(W, N, 64 * kb, 64 * nb, WT, drow, ldd, scr, lane, ksc);
        }
        {
            LAS float* scr32 = (LAS float*)lds + wave * (64 * 65);
            bf16* RK = (bf16*)(ws + WS_RKVLOT);
            for (int it = gw; it < 2048; it += NGW) {
                if (it < 768) { const int q = it / 384, r = it % 384, e = r / 192, t = r % 192, kb = t / 3, nb = t % 3;
                    tr_tile32(p.in[q ? 18 : 15] + (size_t)e * D * LOR, LOR, 32 * kb, 32 * nb, RK, (size_t)(q ? 6400 : 6144) + 96 * e + 32 * nb, D, scr32, lane); }
                else if (it < 1536) { const int r0_ = it - 768, q = r0_ / 384, r = r0_ % 384, e = r / 192, t = r % 192, kb = t / 64, nb = t % 64;
                    tr_tile32(p.in[q ? 19 : 16] + (size_t)e * LOR * D, D, 32 * kb, 32 * nb, (bf16*)(ws + (q ? WS_AW2T : WS_DW2T)), (size_t)e * D + 32 * nb, LOR, scr32, lane); }
                else { const int t = it - 1536, kb = t / 64, nb = t % 64;
                    tr_tile32(p.in[21], D, 32 * kb, 32 * nb, (bf16*)(ws + WS_G2T), (size_t)32 * nb, LOG, scr32, lane); }
            }
            const int gt = bid * 512 + tid, GT = G * 512;
            for (int i = gt; i < 64 * D; i += GT) { RK[(size_t)(6144 + 192) * D + i] = 0; RK[(size_t)(6400 + 192) * D + i] = 0; }
        }
        __syncthreads();
        LAS float* rs = (LAS float*)lds;
        bf16* PO = (bf16*)(ws + WS_POOLED);
        for (int chunk = bid; chunk < NCHUNK; chunk += G) {
            const int r0 = chunk * 64, blo = (r0 / SEQ) * SEQ, bhi = blo + SEQ;
            for (int i = 0; i < 10; ++i) { const int rr = r0 - 8 + wave * 10 + i; if (rr >= blo && rr < bhi) { const float ss = row_sumsq(x + (size_t)rr * D, lane); if (lane == 0) rs[wave * 10 + i] = rstd_of(ss); } }
            __syncthreads();
            const int hf = tid >> 8, c = 8 * (tid & 255), Wh = 1 << ((tid & 255) >> 6);
            const f32x4 gam0 = *(const GAS f32x4*)(p.in[1] + c), gam1 = *(const GAS f32x4*)(p.in[1] + c + 4);
            const int rbeg = r0 + 32 * hf;
            f32x4 s0 = (f32x4){0.f, 0.f, 0.f, 0.f}, s1 = s0;
            for (int rr = max(rbeg - Wh, blo); rr < min(rbeg + Wh, bhi); ++rr) { const float sc = rs[rr - (r0 - 8)]; s0 = s0 + *(const GAS f32x4*)(x + (size_t)rr * D + c) * sc; s1 = s1 + *(const GAS f32x4*)(x + (size_t)rr * D + c + 4) * sc; }
            for (int t = 0; t < 32; ++t) { const int row = rbeg + t; const int s_lo = max(row - Wh, blo), s_hi = min(row + Wh, bhi);
                const float sc = rs[row - (r0 - 8)], inv = 1.0f / (float)(s_hi - s_lo);
                const f32x4 c0 = *(const GAS f32x4*)(x + (size_t)row * D + c) * sc, c1 = *(const GAS f32x4*)(x + (size_t)row * D + c + 4) * sc;
                const f32x4 o0 = (s0 * inv - c0) * gam0, o1 = (s1 * inv - c1) * gam1;
                *(GAS u32x4*)(PO + (size_t)row * D + c) = (u32x4){cvt_pk_bf16(o0.x, o0.y), cvt_pk_bf16(o0.z, o0.w), cvt_pk_bf16(o1.x, o1.y), cvt_pk_bf16(o1.z, o1.w)};
                const int ent = row + Wh, lev = row - Wh;
                if (ent < bhi) { const float se = rs[ent - (r0 - 8)]; s0 = s0 + *(const GAS f32x4*)(x + (size_t)ent * D + c) * se; s1 = s1 + *(const GAS f32x4*)(x + (size_t)ent * D + c + 4) * se; }
                if (lev >= blo) { const float sl = rs[lev - (r0 - 8)]; s0 = s0 - *(const GAS f32x4*)(x + (size_t)lev * D + c) * sl; s1 = s1 - *(const GAS f32x4*)(x + (size_t)lev * D + c + 4) * sl; } }
            __syncthreads();
        }
    }
    SEAM(0);

    if (IN(1)) {
        pg8::Gemm g{(const bf16*)(ws + WS_POOLED), (const bf16*)(ws + WS_POOLT), D, 512, 512};
        SchedPool S; S.T.init(M / 256, 8, G, bid);
        pg8::EpiPool E{x, Hh, p.in[3], (LAS float*)(lds + 131072), (float*)(ws + WS_PART)};
        pg8::gemm_phase<pg8::EpiPool, SchedPool, true, true>(lds, g, S, E);
    }
    SEAM(1);


    if (IN(3)) for (int rep_ = 0; rep_ < REP3; ++rep_) {
        pg8::Gemm g{(const bf16*)Hh, (const bf16*)(ws + WS_FFN1T), D, D, D};
        SchedPlain S; S.T.init(M / 256, 2 * FF0 / 256, G, bid); S.astep = (unsigned long long)256 * D * 2; S.bstep = (unsigned long long)256 * D * 2;
        if constexpr (FFN_DOWN_FP8) { pg8::EpiSwigluF8R E{ws + WS_ACT0, FF0, F8_SH0, (const float*)(ws + WS_PART)}; pg8::gemm_phase(lds, g, S, E); }
        else { pg8::EpiSwiglu E{(bf16*)(ws + WS_ACT0), FF0, (const float*)(ws + WS_PART)}; pg8::gemm_phase(lds, g, S, E); }
    }
    SEAM(3);

    if (IN(4)) {
        constexpr int KU = FFN_DOWN_FP8 ? FF0 / 2 : FF0;
        pg8::Gemm g{(const bf16*)(ws + WS_ACT0), (const bf16*)(ws + WS_FFN2T), KU, KU, KU};
        SchedPlain S; S.T.init(M / 256, D / 256, G, bid); S.astep = (unsigned long long)256 * KU * 2; S.bstep = (unsigned long long)256 * KU * 2;
        pg8::EpiResid E{Hh, FFN_DOWN_FP8 ? 1.0f / (F8_SH0 * F8_SWD0) : 1.0f};
        pg8::gemm_phase<pg8::EpiResid, SchedPlain, false, true, FFN_DOWN_FP8>(lds, g, S, E);
    }
    SEAM(4);

    if (IN(5)) for (int rep_ = 0; rep_ < REP5; ++rep_) {
        LAS float* rs = (LAS float*)lds;
        bf16* MX = (bf16*)(ws + WS_MIX);
        const int hf = tid >> 8, c = 8 * (tid & 255);
        const f32x4 gam0 = *(const GAS f32x4*)(p.in[8] + c), gam1 = *(const GAS f32x4*)(p.in[8] + c + 4);
        f32x4 mc0[6], mc1[6];
#pragma unroll
        for (int i = 0; i < 6; ++i) { mc0[i] = *(const GAS f32x4*)(p.in[9] + (size_t)i * D + c); mc1[i] = *(const GAS f32x4*)(p.in[9] + (size_t)i * D + c + 4); }
        for (int chunk = bid; chunk < NCHUNK; chunk += G) {
            const int r0 = chunk * 64, blo = (r0 / SEQ) * SEQ, bhi = blo + SEQ;
            {
#pragma unroll
                for (int i3 = 0; i3 < 3; ++i3) { u32x4 w[3][4]; bool ok[3];
#pragma unroll
                    for (int q3 = 0; q3 < 3; ++q3) { const int li = wave * 9 + 3 * i3 + q3; const int rr = r0 - 1 + li; ok[q3] = (li < 66 && rr >= blo && rr < bhi); const int rc = ok[q3] ? rr : r0;
#pragma unroll
                        for (int j = 0; j < 4; ++j) w[q3][j] = *(const GAS u32x4*)(Hh + (size_t)rc * D + 8 * lane + 512 * j); }
#pragma unroll
                    for (int q3 = 0; q3 < 3; ++q3) { float ss = 0.f;
#pragma unroll
                        for (int j = 0; j < 4; ++j) { f32x4 a4, c4; unpk8(w[q3][j], a4, c4); ss += ((a4.x * a4.x + a4.y * a4.y) + (a4.z * a4.z + a4.w * a4.w)) + ((c4.x * c4.x + c4.y * c4.y) + (c4.z * c4.z + c4.w * c4.w)); }
                        ss = wave_sum(ss); if (ok[q3] && lane == 0) rs[wave * 9 + 3 * i3 + q3] = rstd_of(ss); } } }
            __syncthreads();
            const f32x4 z4 = (f32x4){0.f, 0.f, 0.f, 0.f};
            const int rbeg = r0 + 32 * hf;
            auto ldrow = [&](int row, u32x4& w) { const int rc = (row >= blo && row < bhi) ? row : r0; w = *(const GAS u32x4*)(Hh + (size_t)rc * D + c); };
            auto cvrow = [&](int row, const u32x4& w, f32x4& o0, f32x4& o1) { if (row >= blo && row < bhi) { const float sc = rs[row - (r0 - 1)]; unpk8(w, o0, o1); o0 = o0 * sc * gam0; o1 = o1 * sc * gam1; } else { o0 = z4; o1 = z4; } };
            u32x4 wp, wc, wa, wb; ldrow(rbeg - 1, wp); ldrow(rbeg, wc); ldrow(rbeg + 1, wa);
            f32x4 p0, p1, c0, c1; cvrow(rbeg - 1, wp, p0, p1); cvrow(rbeg, wc, c0, c1);
            auto step = [&](int row, const u32x4& wnext) {
                f32x4 n0, n1; cvrow(row + 1, wnext, n0, n1);
                const f32x4 x0 = (p0 + n0) * 0.5f - c0, x1 = (p1 + n1) * 0.5f - c1;
#pragma unroll
                for (int i = 0; i < 6; ++i) { const f32x4 o0 = c0 + x0 * mc0[i], o1 = c1 + x1 * mc1[i];
                    __builtin_nontemporal_store(((u32x4){cvt_pk_bf16(o0.x, o0.y), cvt_pk_bf16(o0.z, o0.w), cvt_pk_bf16(o1.x, o1.y), cvt_pk_bf16(o1.z, o1.w)}), (GAS u32x4*)(MX + ((size_t)i * M + row) * D + c)); }
                p0 = c0; p1 = c1; c0 = n0; c1 = n1; };
            for (int t = 0; t < 32; t += 2) { const int row = rbeg + t;
                ldrow(row + 2, wb); step(row, wa);
                ldrow(row + 3, wa); step(row + 1, wb); }
            __syncthreads();
        }
    }
    SEAM(5);

    if (IN(6)) for (int rep_ = 0; rep_ < REP6; ++rep_) {
        pg8::Gemm g{(const bf16*)(ws + WS_MIX), (const bf16*)(ws + WS_RKVLOT), D, D, D};
        SchedRkvLo S; S.T.init(M / 256, 27, G, bid);
        pg8::EpiRkvLo E{(bf16*)(ws + WS_RKV), (bf16*)(ws + WS_LO)};
        pg8::gemm_phase(lds, g, S, E);
    }
    SEAM(6);

    if (IN(7)) for (int rep_ = 0; rep_ < REP7; ++rep_) {
        const bf16* LO_ = (const bf16*)(ws + WS_LO);
        for (int it = gw; it < 512 * 5 * 4; it += NGW) {
            const int cq = it & 3, tq = (it >> 2) % 5, rt = (it >> 2) / 5; const int m0 = rt * 32, n0 = cq * 512;
            if (tq < 2) lora_up_item<0>(LO_ + 96 * tq, 256, (const bf16*)(ws + WS_DW2T) + (size_t)tq * D * LOR, p.in[14] + (size_t)tq * D, (bf16*)(ws + WS_EW) + (size_t)tq * M * D, m0, n0, lane, lds + wave * 4608);
            else if (tq < 4) lora_up_item<1>(LO_ + (size_t)M * 256 + 96 * (tq - 2), 256, (const bf16*)(ws + WS_AW2T) + (size_t)(tq - 2) * D * LOR, p.in[17] + (size_t)(tq - 2) * D, (bf16*)(ws + WS_AA) + (size_t)(tq - 2) * M * D, m0, n0, lane, lds + wave * 4608);
            else lora_up_item_k256(LO_ + (size_t)2 * M * 256, (const bf16*)(ws + WS_G2T), (bf16*)(ws + WS_GG), m0, n0, lane, lds + wave * 4608);
        }
    }
    SEAM(7);

    if (IN(8)) for (int rep_ = 0; rep_ < REP8; ++rep_) {
        constexpr int PT = 144;
        constexpr int OFF_AT = 0, OFF_RT = 9216, OFF_BM = 18432, OFF_KM = 27648, OFF_BMT = 36864, OFF_KMT = 46080, OFF_VT = 55296;
        constexpr int OFF_LAB = 64512, OFF_LAK = 73728, OFF_MRB = 82944, OFF_MRK = 92160, OFF_TBB = 101376, OFF_LD = 103424, OFF_GC = 107520, OFF_WTOT = 107776, OFF_YB = 109824;
        const int q = lane >> 4, c16 = lane & 15;
        const bf16* RKV = (const bf16*)(ws + WS_RKV);
#define WK_NAT(off, row, kb) (*(const LAS bf16x8*)(lds + (off) + (row) * PT + ((kb) + 8 * q) * 2))
#define WK_MFMA(a, b, c) __builtin_amdgcn_mfma_f32_16x16x32_bf16((a), (b), (c), 0, 0, 0)
        auto ld_rho = [&](int off, int row, int kb) -> bf16x8 {
            const u32x2 lo2 = *(const LAS u32x2*)(lds + off + row * PT + (kb + 4 * q) * 2), hi2 = *(const LAS u32x2*)(lds + off + row * PT + (kb + 16 + 4 * q) * 2);
            const u32x4 w4 = (u32x4){lo2.x, lo2.y, hi2.x, hi2.y}; return __builtin_bit_cast(bf16x8, w4); };
        auto packB = [&](const f32x4& a, const f32x4& b) -> bf16x8 {
            const u32x4 w4 = (u32x4){cvt_pk_bf16(a[0], a[1]), cvt_pk_bf16(a[2], a[3]), cvt_pk_bf16(b[0], b[1]), cvt_pk_bf16(b[2], b[3])}; return __builtin_bit_cast(bf16x8, w4); };
        for (int i = tid; i < (OFF_LD - OFF_LAB) / 16; i += 512) *(LAS u32x4*)(lds + OFF_LAB + i * 16) = (u32x4){0u, 0u, 0u, 0u};
        __syncthreads();
        if (bid < 2 * BATCH * NH) { const int u = bid;
            const int dir = u / (BATCH * NH), b = (u % (BATCH * NH)) / NH, h = u % NH;
            const bool fwd = (dir == 0);
            const size_t rowbase = (size_t)b * SEQ; const int col = h * HS + lane;
            const bf16* EW = (const bf16*)(ws + WS_EW) + (size_t)dir * M * D; const bf16* AA = (const bf16*)(ws + WS_AA) + (size_t)dir * M * D;
            bf16* Yo = (bf16*)(ws + WS_Y) + (size_t)dir * M * D;
            const float kkc = p.in[22][col], kac = p.in[23][col], rkc = p.in[24][col];
            float* BSo = (float*)(ws + WS_BS) + (size_t)dir * M * NH;
            constexpr int OFF_PM = 126464;
            static_assert(OFF_PM + 64 * PT <= MISC_OFF, "Pm");
            f32x4 ST[4];
#pragma unroll
            for (int i = 0; i < 4; ++i) ST[i] = (f32x4){0.f, 0.f, 0.f, 0.f};
            constexpr int OFF_RAW = OFF_LAB;
            auto ldraw = [&](int cc, u32x4 (&pf)[5]) { cc = (cc < SEQ / 64) ? cc : SEQ / 64 - 1;
                const int tl = cc * 64 + 8 * wave + (lane >> 3); const int t = fwd ? tl : SEQ - 1 - tl; const size_t o = (rowbase + t) * D + h * HS + 8 * (lane & 7);
                pf[0] = __builtin_nontemporal_load((const GAS u32x4*)(RKV + o)); pf[1] = __builtin_nontemporal_load((const GAS u32x4*)(RKV + (size_t)M * D + o)); pf[2] = __builtin_nontemporal_load((const GAS u32x4*)(RKV + (size_t)2 * M * D + o));
                pf[3] = __builtin_nontemporal_load((const GAS u32x4*)(EW + o)); pf[4] = __builtin_nontemporal_load((const GAS u32x4*)(AA + o)); };
            u32x4 pfA[5], pfB[5];
            ldraw(0, pfA); ldraw(1, pfB);
            auto chunk_body = [&](const int c, u32x4 (&pf)[5]) __attribute__((always_inline)) {
                {
                    const int cp = (c > 0) ? c - 1 : 0;
#pragma unroll
                    for (int j = 0; j < 8; ++j) { const int tl = cp * 64 + 8 * wave + j; const int t = fwd ? tl : SEQ - 1 - tl;
                        Yo[(rowbase + t) * D + col] = (bf16)cvt_pk_bf16(((const LAS float*)(lds + OFF_YB))[(8 * wave + j) * 65 + lane], 0.f); } }
#pragma unroll
                for (int x5 = 0; x5 < 5; ++x5) *(LAS u32x4*)(lds + OFF_RAW + x5 * 8192 + (8 * wave + (lane >> 3)) * 128 + (lane & 7) * 16) = pf[x5];
                ldraw(c + 2, pf);
                f32x4 cvb[16]; const int cvit = (c * NCW + (wave - CVW0)) * 256 + bid;
                LDS_WAIT(); __builtin_amdgcn_s_barrier(); asm volatile("" ::: "memory");
                unsigned short rr_[8], rk_[8], rv_[8], re_[8], ra_[8];
#pragma unroll
                for (int j = 0; j < 8; ++j) { const LAS unsigned short* rp = (const LAS unsigned short*)(lds + OFF_RAW + (8 * wave + j) * 128 + lane * 2);
                    rr_[j] = rp[0]; rk_[j] = rp[4096]; rv_[j] = rp[8192]; re_[j] = rp[12288]; ra_[j] = rp[16384]; }
                float lgl[8]; { float cs = 0.f;
#pragma unroll
                    for (int j = 0; j < 8; ++j) { cs -= bf2f(re_[j]); lgl[j] = cs; } }
                ((LAS float*)(lds + OFF_WTOT))[wave * 64 + lane] = lgl[7];
                LDS_WAIT(); __builtin_amdgcn_s_barrier(); asm volatile("" ::: "memory");
                float off = 0.f;
                { float wt[8];
#pragma unroll
                  for (int w2 = 0; w2 < 8; ++w2) wt[w2] = ((const LAS float*)(lds + OFF_WTOT))[w2 * 64 + lane];
#pragma unroll
                  for (int w2 = 0; w2 < 7; ++w2) off += (w2 < wave) ? wt[w2] : 0.f; }
                {
                    unsigned bt[8], kt[8];
                    float rig_prev = __expf(off);
#pragma unroll
                    for (int j = 0; j < 8; ++j) { const int t = 8 * wave + j;
                        const float lg = off + lgl[j];
                        const float rf = bf2f(rr_[j]), kf = bf2f(rk_[j]), af = bf2f(ra_[j]);
                        const float kkr = kf * kkc; const float n2 = wave_sum(kkr * kkr); const float kkn = kkr * __builtin_amdgcn_rsqf(fmaxf(n2, 1e-24f));
                        const float ig = __expf(-lg), gt = __builtin_amdgcn_rcpf(ig), eg = rig_prev;
                        rig_prev = gt;
                        const unsigned ar_ = cvt_pk_bf16(-kkn * eg, rf * (fwd ? gt : eg));
                        const float kmod = kf * (1.0f + (af - 1.0f) * kac);
                        const unsigned bk_ = cvt_pk_bf16(kkn * af * ig, kmod * ig);
                        *(LAS unsigned short*)(lds + OFF_PM + t * PT + lane * 2) = (unsigned short)cvt_pk_bf16(rf * kmod * rkc, 0.f);
                        *(LAS unsigned short*)(lds + OFF_AT + t * PT + lane * 2) = (unsigned short)ar_;
                        *(LAS unsigned short*)(lds + OFF_RT + t * PT + lane * 2) = (unsigned short)(ar_ >> 16);
                        *(LAS unsigned short*)(lds + OFF_BM + t * PT + lane * 2) = (unsigned short)bk_;
                        *(LAS unsigned short*)(lds + OFF_KM + t * PT + lane * 2) = (unsigned short)(bk_ >> 16);
                        bt[j] = bk_ & 0xffffu; kt[j] = bk_ >> 16; }
                    *(LAS u32x4*)(lds + OFF_BMT + lane * PT + wave * 16) = (u32x4){bt[0] | (bt[1] << 16), bt[2] | (bt[3] << 16), bt[4] | (bt[5] << 16), bt[6] | (bt[7] << 16)};
                    *(LAS u32x4*)(lds + OFF_KMT + lane * PT + wave * 16) = (u32x4){kt[0] | (kt[1] << 16), kt[2] | (kt[3] << 16), kt[4] | (kt[5] << 16), kt[6] | (kt[7] << 16)};
                    *(LAS u32x4*)(lds + OFF_VT + lane * PT + wave * 16) = (u32x4){(unsigned)rv_[0] | ((unsigned)rv_[1] << 16), (unsigned)rv_[2] | ((unsigned)rv_[3] << 16), (unsigned)rv_[4] | ((unsigned)rv_[5] << 16), (unsigned)rv_[6] | ((unsigned)rv_[7] << 16)};
                    {
                        const int mtx = tid >> 7, tl2 = (tid >> 6) & 1, r16 = (tid >> 2) & 15;
                        const int offM = (mtx == 0) ? OFF_LAK : (mtx == 1) ? OFF_MRB : (mtx == 2) ? OFF_MRK : OFF_LAB;
                        *(LAS u32x2*)(lds + offM + (32 * tl2 + r16) * PT + (32 * tl2 + 16) * 2 + (tid & 3) * 8) = (u32x2){0u, 0u}; }
                    if (wave == 7) ((LAS float*)(lds + OFF_GC))[lane] = __expf(off + lgl[7]);
                }
                LDS_WAIT(); __builtin_amdgcn_s_barrier(); asm volatile("" ::: "memory");
                auto s1_tile = [&](int pr, int tt, int it) {
                    const int offX = (pr & 1) ? OFF_KM : OFF_BM, offY = (pr & 2) ? OFF_RT : OFF_AT;
                    const int offD = (pr == 0) ? OFF_LAB : (pr == 1) ? OFF_LAK : (pr == 2) ? OFF_MRB : OFF_MRK;
                    const bf16x8 x0 = WK_NAT(offX, 16 * it + c16, 0), x1 = WK_NAT(offX, 16 * it + c16, 32), y0 = WK_NAT(offY, 16 * tt + c16, 0), y1 = WK_NAT(offY, 16 * tt + c16, 32);
                    f32x4 acc = (f32x4){0.f, 0.f, 0.f, 0.f};
                    acc = WK_MFMA(x0, y0, acc); acc = WK_MFMA(x1, y1, acc);
                    const int t = 16 * tt + c16, i0 = 16 * it + 4 * q; const bool incl = (pr >= 2) && fwd;
#pragma unroll
                    for (int r4 = 0; r4 < 4; ++r4) { const int i = i0 + r4; const bool keep = incl ? (i <= t) : (i < t); acc[r4] = keep ? acc[r4] : 0.f; }
                    *(LAS u32x2*)(lds + offD + t * PT + i0 * 2) = (u32x2){cvt_pk_bf16(acc[0], acc[1]), cvt_pk_bf16(acc[2], acc[3])};
                    if (pr == 0 && tt == it) {
#pragma unroll
                        for (int r4 = 0; r4 < 4; ++r4) *(LAS float*)(lds + OFF_LD + tt * 1024 + (4 * q + r4) * 64 + c16 * 4) = acc[r4]; } };
                auto tile_of = [&](int ti, int& tt, int& it) { tt = (ti >= 6) ? 3 : (ti >= 3) ? 2 : (ti >= 1) ? 1 : 0; it = ti - (tt * (tt + 1)) / 2; };
                for (int n3 = 0; n3 < 3; ++n3) { const int a = wave * 3 + n3; int pr, tt, it;
                    if (a < 4) { pr = 0; tt = a; it = a; } else if (a < 14) { pr = 1; tile_of(a - 4, tt, it); } else { pr = 3; tile_of(a - 14, tt, it); }
                    s1_tile(pr, tt, it); }
                if (wave >= 4) {
                    const int blk = wave - 4; const bf16x8 ones = __builtin_bit_cast(bf16x8, ((u32x4){0x3F803F80u, 0x3F803F80u, 0x3F803F80u, 0x3F803F80u}));
                    f32x4 bsum = WK_MFMA(WK_NAT(OFF_PM, 16 * blk + c16, 0), ones, ((f32x4){0.f, 0.f, 0.f, 0.f})); bsum = WK_MFMA(WK_NAT(OFF_PM, 16 * blk + c16, 32), ones, bsum);
                    if (c16 == 0) {
#pragma unroll
                        for (int r4 = 0; r4 < 4; ++r4) { int ozb; asm volatile("v_mov_b32 %0, 0" : "=v"(ozb)); const int tlb = c * 64 + 16 * blk + 4 * (q + ozb) + r4; const int tb = fwd ? tlb : SEQ - 1 - tlb; BSo[(rowbase + tb) * NH + h] = bsum[r4]; } } }
                LDS_WAIT(); __builtin_amdgcn_s_barrier(); asm volatile("" ::: "memory");
                const f32x4 z4 = (f32x4){0.f, 0.f, 0.f, 0.f};
                bf16x8 Sb[2], Vb[2]; f32x4 accA[4], yv[4], sacc[4];
                if (wave == 4) {
                    if (CVW0 <= 4) moe_cv_load(p.in, cvit, cvb, lane);
                    {
                    float Tr[16];
                    const LAS float* Lq = (const LAS float*)(lds + OFF_LD + q * 1024);
                    int oz4; asm volatile("v_mov_b32 %0, 0" : "=v"(oz4));
#pragma unroll
                    for (int r = 0; r < 16; ++r) Tr[r] = (r == c16 + oz4) ? 1.0f : 0.0f;
#pragma unroll
                    for (int i = 0; i < 15; ++i) {
#pragma unroll
                        for (int k4 = (i + 1) / 4; k4 < 4; ++k4) { const f32x4 lv = *(const LAS f32x4*)(Lq + i * 16 + 4 * k4);
#pragma unroll
                            for (int e = 0; e < 4; ++e) if (4 * k4 + e > i) Tr[4 * k4 + e] += lv[e] * Tr[i]; } }
#pragma unroll
                    for (int r = 0; r < 16; ++r) *(LAS unsigned short*)(lds + OFF_TBB + q * 512 + r * 32 + c16 * 2) = (unsigned short)cvt_pk_bf16(Tr[r], 0.f);
                    }
                    LDS_WAIT(); __builtin_amdgcn_s_barrier(); asm volatile("" ::: "memory");
                    if (CVW0 <= 4) moe_cv_store(ws, cvit, cvb, lane);
                } else if (wave > 4) {
                    if (wave >= CVW0) moe_cv_load(p.in, cvit, cvb, lane);
                    f32x2 cvh[16]; const int hidx = (c * 3 + (wave - 5)) * 256 + bid; const bool hon = hidx < MOE_CV_HALVES;
                    if (hon) moe_cvh_load(p.in, MOE_CV_EARLY + (hidx >> 1), hidx & 1, cvh, lane);
                    for (int bb = wave - 5; bb < 16; bb += 3) { int pr, tt, it;
                        if (bb < 6) { pr = 0; const int ti = (bb == 0) ? 1 : (bb == 1) ? 3 : (bb == 2) ? 4 : (bb == 3) ? 6 : (bb == 4) ? 7 : 8; tile_of(ti, tt, it); } else { pr = 2; tile_of(bb - 6, tt, it); }
                        s1_tile(pr, tt, it); }
                    LDS_WAIT(); __builtin_amdgcn_s_barrier(); asm volatile("" ::: "memory");
                    if (wave >= CVW0) moe_cv_store(ws, cvit, cvb, lane);
                    if (hon) moe_cvh_store(ws, MOE_CV_EARLY + (hidx >> 1), hidx & 1, cvh, lane);
                } else {
                    Sb[0] = packB(ST[0], ST[1]); Sb[1] = packB(ST[2], ST[3]);
                    Vb[0] = WK_NAT(OFF_VT, 16 * wave + c16, 0); Vb[1] = WK_NAT(OFF_VT, 16 * wave + c16, 32);
                    {
                        bf16x8 fLak[6], fAt[8];
                        fLak[0] = WK_NAT(OFF_LAK, c16, 0); fLak[1] = WK_NAT(OFF_LAK, 16 + c16, 0); fLak[2] = WK_NAT(OFF_LAK, 32 + c16, 0); fLak[3] = WK_NAT(OFF_LAK, 32 + c16, 32); fLak[4] = WK_NAT(OFF_LAK, 48 + c16, 0); fLak[5] = WK_NAT(OFF_LAK, 48 + c16, 32);
#pragma unroll
                        for (int blk = 0; blk < 4; ++blk) { fAt[2 * blk] = ld_rho(OFF_AT, 16 * blk + c16, 0); fAt[2 * blk + 1] = ld_rho(OFF_AT, 16 * blk + c16, 32); }
                        __builtin_amdgcn_sched_barrier(0);
                        accA[0] = WK_MFMA(fLak[0], Vb[0], z4); accA[0] = WK_MFMA(fAt[0], Sb[0], accA[0]); accA[0] = WK_MFMA(fAt[1], Sb[1], accA[0]);
                        accA[1] = WK_MFMA(fLak[1], Vb[0], z4); accA[1] = WK_MFMA(fAt[2], Sb[0], accA[1]); accA[1] = WK_MFMA(fAt[3], Sb[1], accA[1]);
                        accA[2] = WK_MFMA(fLak[2], Vb[0], z4); accA[2] = WK_MFMA(fLak[3], Vb[1], accA[2]); accA[2] = WK_MFMA(fAt[4], Sb[0], accA[2]); accA[2] = WK_MFMA(fAt[5], Sb[1], accA[2]);
                        accA[3] = WK_MFMA(fLak[4], Vb[0], z4); accA[3] = WK_MFMA(fLak[5], Vb[1], accA[3]); accA[3] = WK_MFMA(fAt[6], Sb[0], accA[3]); accA[3] = WK_MFMA(fAt[7], Sb[1], accA[3]);
                    }
                    __builtin_amdgcn_sched_barrier(0);
                    {
                        bf16x8 fRt[8], fMrk[6];
#pragma unroll
                        for (int blk = 0; blk < 4; ++blk) { fRt[2 * blk] = ld_rho(OFF_RT, 16 * blk + c16, 0); fRt[2 * blk + 1] = ld_rho(OFF_RT, 16 * blk + c16, 32); }
                        fMrk[0] = WK_NAT(OFF_MRK, c16, 0); fMrk[1] = WK_NAT(OFF_MRK, 16 + c16, 0); fMrk[2] = WK_NAT(OFF_MRK, 32 + c16, 0); fMrk[3] = WK_NAT(OFF_MRK, 32 + c16, 32); fMrk[4] = WK_NAT(OFF_MRK, 48 + c16, 0); fMrk[5] = WK_NAT(OFF_MRK, 48 + c16, 32);
                        __builtin_amdgcn_sched_barrier(0);
                        yv[0] = WK_MFMA(fRt[0], Sb[0], z4); yv[0] = WK_MFMA(fRt[1], Sb[1], yv[0]); yv[0] = WK_MFMA(fMrk[0], Vb[0], yv[0]);
                        yv[1] = WK_MFMA(fRt[2], Sb[0], z4); yv[1] = WK_MFMA(fRt[3], Sb[1], yv[1]); yv[1] = WK_MFMA(fMrk[1], Vb[0], yv[1]);
                        yv[2] = WK_MFMA(fRt[4], Sb[0], z4); yv[2] = WK_MFMA(fRt[5], Sb[1], yv[2]); yv[2] = WK_MFMA(fMrk[2], Vb[0], yv[2]); yv[2] = WK_MFMA(fMrk[3], Vb[1], yv[2]);
                        yv[3] = WK_MFMA(fRt[6], Sb[0], z4); yv[3] = WK_MFMA(fRt[7], Sb[1], yv[3]); yv[3] = WK_MFMA(fMrk[4], Vb[0], yv[3]); yv[3] = WK_MFMA(fMrk[5], Vb[1], yv[3]);
                    }
                    __builtin_amdgcn_sched_barrier(0);
                    {
                        bf16x8 fK[8];
#pragma unroll
                        for (int kt = 0; kt < 4; ++kt) { fK[2 * kt] = WK_NAT(OFF_KMT, 16 * kt + c16, 0); fK[2 * kt + 1] = WK_NAT(OFF_KMT, 16 * kt + c16, 32); }
                        __builtin_amdgcn_sched_barrier(0);
#pragma unroll
                        for (int kt = 0; kt < 4; ++kt) { sacc[kt] = WK_MFMA(fK[2 * kt], Vb[0], ST[kt]); sacc[kt] = WK_MFMA(fK[2 * kt + 1], Vb[1], sacc[kt]); }
                    }
                    LDS_WAIT(); __builtin_amdgcn_s_barrier(); asm volatile("" ::: "memory");
                    bf16x8 fLab[4]; u32x2 fT[4];
                    fLab[0] = ld_rho(OFF_LAB, 16 + c16, 0); fLab[1] = ld_rho(OFF_LAB, 32 + c16, 0); fLab[2] = ld_rho(OFF_LAB, 48 + c16, 0); fLab[3] = ld_rho(OFF_LAB, 48 + c16, 32);
#pragma unroll
                    for (int blk = 0; blk < 4; ++blk) fT[blk] = *(const LAS u32x2*)(lds + OFF_TBB + blk * 512 + c16 * 32 + q * 8);
                    __builtin_amdgcn_sched_barrier(0);
                    f32x4 U[4]; bf16x8 Ub0, Ub1;
                    U[0] = WK_MFMA(__builtin_bit_cast(bf16x8, ((u32x4){fT[0].x, fT[0].y, 0u, 0u})), packB(accA[0], z4), z4);
                    accA[1] = WK_MFMA(fLab[0], packB(U[0], z4), accA[1]);
                    U[1] = WK_MFMA(__builtin_bit_cast(bf16x8, ((u32x4){fT[1].x, fT[1].y, 0u, 0u})), packB(accA[1], z4), z4);
                    Ub0 = packB(U[0], U[1]);
                    accA[2] = WK_MFMA(fLab[1], Ub0, accA[2]);
                    U[2] = WK_MFMA(__builtin_bit_cast(bf16x8, ((u32x4){fT[2].x, fT[2].y, 0u, 0u})), packB(accA[2], z4), z4);
                    accA[3] = WK_MFMA(fLab[2], Ub0, accA[3]); accA[3] = WK_MFMA(fLab[3], packB(U[2], z4), accA[3]);
                    U[3] = WK_MFMA(__builtin_bit_cast(bf16x8, ((u32x4){fT[3].x, fT[3].y, 0u, 0u})), packB(accA[3], z4), z4);
                    Ub1 = packB(U[2], U[3]);
                    __builtin_amdgcn_sched_barrier(0);
                    bf16x8 fMrb[6], fB[8]; f32x4 gc[4];
                    fMrb[0] = ld_rho(OFF_MRB, c16, 0); fMrb[1] = ld_rho(OFF_MRB, 16 + c16, 0); fMrb[2] = ld_rho(OFF_MRB, 32 + c16, 0); fMrb[3] = ld_rho(OFF_MRB, 32 + c16, 32); fMrb[4] = ld_rho(OFF_MRB, 48 + c16, 0); fMrb[5] = ld_rho(OFF_MRB, 48 + c16, 32);
#pragma unroll
                    for (int kt = 0; kt < 4; ++kt) { fB[2 * kt] = ld_rho(OFF_BMT, 16 * kt + c16, 0); fB[2 * kt + 1] = ld_rho(OFF_BMT, 16 * kt + c16, 32); gc[kt] = *(const LAS f32x4*)(lds + OFF_GC + (16 * kt + 4 * q) * 4); }
                    __builtin_amdgcn_sched_barrier(0);
                    yv[0] = WK_MFMA(fMrb[0], Ub0, yv[0]); yv[1] = WK_MFMA(fMrb[1], Ub0, yv[1]);
                    yv[2] = WK_MFMA(fMrb[2], Ub0, yv[2]); yv[2] = WK_MFMA(fMrb[3], Ub1, yv[2]);
                    yv[3] = WK_MFMA(fMrb[4], Ub0, yv[3]); yv[3] = WK_MFMA(fMrb[5], Ub1, yv[3]);
#pragma unroll
                    for (int kt = 0; kt < 4; ++kt) { f32x4 a = WK_MFMA(fB[2 * kt], Ub0, sacc[kt]); a = WK_MFMA(fB[2 * kt + 1], Ub1, a); ST[kt] = a * gc[kt]; }
#pragma unroll
                    for (int blk = 0; blk < 4; ++blk)
#pragma unroll
                        for (int i = 0; i < 4; ++i) ((LAS float*)(lds + OFF_YB))[(16 * blk + 4 * q + i) * 65 + 16 * wave + c16] = yv[blk][i];
                }
                LDS_WAIT(); __builtin_amdgcn_s_barrier(); asm volatile("" ::: "memory");
            };
            for (int c2 = 0; c2 < SEQ / 64; c2 += 2) { chunk_body(c2, pfA); chunk_body(c2 + 1, pfB); }
            {
#pragma unroll
                for (int j = 0; j < 8; ++j) { const int tl = (SEQ / 64 - 1) * 64 + 8 * wave + j; const int t = fwd ? tl : SEQ - 1 - tl;
                    Yo[(rowbase + t) * D + col] = (bf16)cvt_pk_bf16(((const LAS float*)(lds + OFF_YB))[(8 * wave + j) * 65 + lane], 0.f); }
            }
            __syncthreads();
        }
#undef WK_NAT
#undef WK_MFMA
        __syncthreads();
    }
    SEAM(8);

    if (IN(9)) for (int rep_ = 0; rep_ < REP9; ++rep_) {
        const bf16* YF = (const bf16*)(ws + WS_Y); const bf16* YB = YF + (size_t)M * D;
        const bf16* RKV = (const bf16*)(ws + WS_RKV); const float* BS = (const float*)(ws + WS_BS); const bf16* GG = (const bf16*)(ws + WS_GG);
        bf16* PO = (bf16*)(ws + WS_PO);
        auto unpk = [](const u32x4& w, float (&f)[8]) {
#pragma unroll
            for (int i = 0; i < 4; ++i) { f[2 * i] = __uint_as_float(w[i] << 16); f[2 * i + 1] = __uint_as_float(w[i] & 0xffff0000u); } };
        auto row8_sum = [](float v) { v += dppmov<0xB1>(v); v += dppmov<0x4E>(v); v += dppmov<0x141>(v); return v; };
        for (int j = 0; j < 4; ++j) { const int cc = 8 * lane + 512 * j;
            float lw[8], lb[8];
#pragma unroll
            for (int i = 0; i < 8; ++i) { lw[i] = p.in[25][cc + i]; lb[i] = p.in[26][cc + i]; }
            for (int m = gw; m < M; m += NGW) { const size_t o = (size_t)m * D + cc;
                const u32x4 yfw = __builtin_nontemporal_load((const GAS u32x4*)(YF + o)), ybw = __builtin_nontemporal_load((const GAS u32x4*)(YB + o)), vw = __builtin_nontemporal_load((const GAS u32x4*)(RKV + (size_t)2 * M * D + o));
                const u32x4 gw4 = __builtin_nontemporal_load((const GAS u32x4*)(GG + o));
                const float bs = BS[(size_t)m * NH + (lane >> 3) + 8 * j];
                float yf[8], yb[8], vf[8], gf[8], y[8];
                unpk(yfw, yf); unpk(ybw, yb); unpk(vw, vf); unpk(gw4, gf);
                float s = 0.f;
#pragma unroll
                for (int i = 0; i < 8; ++i) { y[i] = yf[i] + yb[i]; s += y[i]; }
                const float mu = row8_sum(s) * (1.0f / 64.0f);
                float qv = 0.f;
#pragma unroll
                for (int i = 0; i < 8; ++i) { y[i] -= mu; qv += y[i] * y[i]; }
                const float rstd = 1.0f / sqrtf(row8_sum(qv) * (1.0f / 64.0f) + LNX_EPS);
                float ov[8];
#pragma unroll
                for (int i = 0; i < 8; ++i) ov[i] = (y[i] * rstd * lw[i] + lb[i] + vf[i] * bs) * gf[i];
                *(GAS u32x4*)(PO + o) = (u32x4){cvt_pk_bf16(ov[0], ov[1]), cvt_pk_bf16(ov[2], ov[3]), cvt_pk_bf16(ov[4], ov[5]), cvt_pk_bf16(ov[6], ov[7])}; }
        }
    }
    SEAM(9);

    if (IN(10)) {
        pg8::Gemm g{(const bf16*)(ws + WS_PO), (const bf16*)(ws + WS_WOT), D, D, D};
        SchedPlain S; S.T.init(M / 256, D / 256, G, bid); S.astep = (unsigned long long)256 * D * 2; S.bstep = (unsigned long long)256 * D * 2;
        pg8::EpiResid E{Hh};
        pg8::gemm_phase<pg8::EpiResid, SchedPlain, false, true>(lds, g, S, E);
    }
    SEAM(10);

    if (IN(11)) for (int rep_ = 0; rep_ < REP11; ++rep_) {
        {
            constexpr int NT_ = MOE_NT;
            auto ld_it = [&](int it, f32x4 (&v)[16]) { moe_cv_load(p.in, it, v, lane); };
            auto st_it = [&](int it, const f32x4 (&v)[16]) { moe_cv_store(ws, it, v, lane); };
            f32x4 va[16], vb[16];
            int it = MOE_CV_EARLY + MOE_CV_HALVES / 2 + gw; if (it < NT_) ld_it(it, va);
            while (it < NT_) {
                int n1 = it + NGW; if (n1 < NT_) ld_it(n1, vb);
                st_it(it, va); it = n1; if (it >= NT_) break;
                int n2 = it + NGW; if (n2 < NT_) ld_it(n2, va);
                st_it(it, vb); it = n2; }
        }
        __syncthreads();
        LAS float* rt = (LAS float*)lds;
        LAS int* lcnt = (LAS int*)(lds + 65536);
        for (int i = tid; i < D * NE; i += 512) { const int c = i >> 3, e = i & 7; const int l = (c & 511) >> 3, j = c >> 9, hf = (c >> 2) & 1, ii = c & 3; rt[((e * 4 + j) * 2 + hf) * 256 + l * 4 + ii] = p.in[28][i]; }
        unsigned char* HN2 = ws + WS_HN2; i32x4* SEL = (i32x4*)(ws + WS_SEL); int* CNT = (int*)(ws + WS_CNT);
        for (int chunk = bid; chunk < NCHUNK; chunk += G) {
            if (tid < 8) lcnt[tid] = 0;
            __syncthreads();
            for (int i = 0; i < 8; ++i) { const int m = chunk * 64 + wave * 8 + i;
                const bf16* xr = Hh + (size_t)m * D; f32x4 v[8]; float s = 0.f;
#pragma unroll
                for (int j = 0; j < 4; ++j) unpk8(__builtin_nontemporal_load((const GAS u32x4*)(xr + 8 * lane + 512 * j)), v[2 * j], v[2 * j + 1]);
#pragma unroll
                for (int j = 0; j < 8; ++j) s += (v[j].x * v[j].x + v[j].y * v[j].y) + (v[j].z * v[j].z + v[j].w * v[j].w);
                const float rsd = rstd_of(wave_sum(s));
                float lg[8];
#pragma unroll
                for (int e = 0; e < 8; ++e) lg[e] = 0.f;
#pragma unroll
                for (int j = 0; j < 4; ++j) { const f32x4 g0 = *(const GAS f32x4*)(p.in[27] + 8 * lane + 512 * j), g1 = *(const GAS f32x4*)(p.in[27] + 8 * lane + 512 * j + 4);
                    const f32x4 h0 = v[2 * j] * rsd * g0, h1 = v[2 * j + 1] * rsd * g1;
                    *(GAS u32x2*)(HN2 + (size_t)m * D + 8 * lane + 512 * j) = (u32x2){pk4_fp8(h0.x * F8_SA, h0.y * F8_SA, h0.z * F8_SA, h0.w * F8_SA), pk4_fp8(h1.x * F8_SA, h1.y * F8_SA, h1.z * F8_SA, h1.w * F8_SA)};
#pragma unroll
                    for (int e = 0; e < 8; ++e) { const f32x4 r0 = *(const LAS f32x4*)(rt + ((e * 4 + j) * 2) * 256 + lane * 4), r1 = *(const LAS f32x4*)(rt + ((e * 4 + j) * 2 + 1) * 256 + lane * 4);
                        lg[e] += ((h0.x * r0.x + h0.y * r0.y) + (h0.z * r0.z + h0.w * r0.w)) + ((h1.x * r1.x + h1.y * r1.y) + (h1.z * r1.z + h1.w * r1.w)); } }
#pragma unroll
                for (int e = 0; e < 8; ++e) lg[e] = wave_sum(lg[e]);
                int e1 = 0; float v1 = lg[0];
#pragma unroll
                for (int e = 1; e < 8; ++e) if (lg[e] > v1) { v1 = lg[e]; e1 = e; }
                int e2 = -1; float v2 = -3.0e38f;
#pragma unroll
                for (int e = 0; e < 8; ++e) if (e != e1 && lg[e] > v2) { v2 = lg[e]; e2 = e; }
                const float g1 = 1.0f / (1.0f + expf(v2 - v1)), g2 = 1.0f - g1;
                if (lane == 0) { SEL[m] = (i32x4){e1 | (e2 << 8), __float_as_int(g1), __float_as_int(g2), 0}; atomicAdd((int*)&lcnt[e1], 1); atomicAdd((int*)&lcnt[e2], 1); }
            }
            __syncthreads();
            if (tid < 8) CNT[chunk * 8 + tid] = lcnt[tid];
            __syncthreads();
        }
    }
    SEAM(11);

    if (IN(12)) for (int rep_ = 0; rep_ < REP12; ++rep_) {
        LAS int* pre = (LAS int*)lds;
        LAS int* tot = pre + NCHUNK * 8;
        LAS int* posb = tot + 32;
        const int* CNT = (const int*)(ws + WS_CNT); const i32x4* SEL = (const i32x4*)(ws + WS_SEL);
        i32x2* META = (i32x2*)(ws + WS_META); unsigned* TILEE = (unsigned*)(ws + WS_TILEE);
        const unsigned char* HN2 = ws + WS_HN2; unsigned char* AG = ws + WS_AG;
        for (int i = tid; i < NCHUNK * 8; i += 512) pre[i] = CNT[i];
        __syncthreads();
        {
            const int e = wave; int v4[4]; int t4 = 0;
#pragma unroll
            for (int k = 0; k < 4; ++k) { v4[k] = pre[(4 * lane + k) * 8 + e]; t4 += v4[k]; }
            int incl = t4;
#pragma unroll
            for (int o = 1; o < 64; o <<= 1) { const int u = __shfl_up(incl, o); if (lane >= o) incl += u; }
            int run = incl - t4;
#pragma unroll
            for (int k = 0; k < 4; ++k) { pre[(4 * lane + k) * 8 + e] = run; run += v4[k]; }
            if (lane == 63) tot[e] = incl; }
        __syncthreads();
        if (tid == 0) { int base = 0; for (int e = 0; e < 8; ++e) { const int nt_ = (tot[e] + 255) >> 8; tot[8 + e] = base; tot[16 + e] = nt_; base += nt_ * 256; } tot[24] = base >> 8; }
        __syncthreads();
        if (bid == 0) {
            if (tid == 0) { int ti = 0; for (int e = 0; e < 8; ++e) for (int k = 0; k < tot[16 + e]; ++k) TILEE[ti++] = (unsigned)e; TILEE[200] = (unsigned)tot[24]; }
        }
        for (int e = bid; e < 8; e += G) { const int pbeg = tot[8 + e] + tot[e], pend = tot[8 + e] + tot[16 + e] * 256;
            for (int r = pbeg + wave; r < pend; r += 8) { if (lane == 0) META[r] = (i32x2){-1, 0};
#pragma unroll
                for (int j = 0; j < 2; ++j) *((GAS u32x4*)(AG + (size_t)r * D) + lane + 64 * j) = (u32x4){0u, 0u, 0u, 0u}; } }
        for (int chunk = bid; chunk < NCHUNK; chunk += G) {
            if (wave == 0) { const int m = chunk * 64 + lane; const i32x4 s = SEL[m]; const int e1 = s.x & 0xff, e2 = (s.x >> 8) & 0xff;
                int p1 = 0, p2 = 0;
#pragma unroll
                for (int e = 0; e < 8; ++e) { const unsigned long long mk = __ballot((e1 == e) || (e2 == e)); const int rank = __popcll(mk & ((1ull << lane) - 1ull)); const int pos = tot[8 + e] + pre[chunk * 8 + e] + rank; if (e1 == e) p1 = pos; if (e2 == e) p2 = pos; }
                posb[2 * lane] = p1; posb[2 * lane + 1] = p2; ((i32x2*)(ws + WS_POS))[m] = (i32x2){p1, p2};
                META[p1] = (i32x2){m, s.y}; META[p2] = (i32x2){m | (1 << 14), s.z}; }
            __syncthreads();
            for (int q = 0; q < 16; ++q) { const int idx = wave * 16 + q; const int m = chunk * 64 + (idx >> 1); const int pos = posb[idx];
                const GAS u32x4* src = (const GAS u32x4*)(HN2 + (size_t)m * D) + lane; GAS u32x4* dst = (GAS u32x4*)(AG + (size_t)pos * D) + lane;
#pragma unroll
                for (int j = 0; j < 2; ++j) dst[64 * j] = __builtin_nontemporal_load(src + 64 * j); }
            __syncthreads();
        }
    }
    SEAM(12);

    if (IN(13)) for (int rep_ = 0; rep_ < REP13; ++rep_) {
        const unsigned* TILEE = (const unsigned*)(ws + WS_TILEE);
        const int ntiles = (int)__builtin_amdgcn_readfirstlane(__hip_atomic_load(TILEE + 200, __ATOMIC_RELAXED, __HIP_MEMORY_SCOPE_AGENT));
        LAS unsigned* tl = (LAS unsigned*)(lds + 131072);
        if (tid < MAXTILES) tl[tid] = __hip_atomic_load(TILEE + tid, __ATOMIC_RELAXED, __HIP_MEMORY_SCOPE_AGENT);
        __syncthreads();
        pg8::Gemm g{(const bf16*)(ws + WS_AG), (const bf16*)(ws + WS_WGUT), D / 2, D / 2, D / 2};
        SchedMoe S; S.T.init(ntiles, 2 * FFE / 256, G, bid); S.tile_e = tl; S.astep = (unsigned long long)256 * D; S.bstep = (unsigned long long)256 * D; S.nN = 2 * FFE / 256;
        pg8::EpiSwigluF8 E{ws + WS_ACT1, FFE, 1.0f / (F8_SA * F8_SWU)};
        pg8::gemm_phase<pg8::EpiSwigluF8, SchedMoe, true, true, true>(lds, g, S, E);
    }
    SEAM(13);

    if (IN(14)) for (int rep_ = 0; rep_ < REP14; ++rep_) {
        const unsigned* TILEE = (const unsigned*)(ws + WS_TILEE);
        const int ntiles = (int)__builtin_amdgcn_readfirstlane(__hip_atomic_load(TILEE + 200, __ATOMIC_RELAXED, __HIP_MEMORY_SCOPE_AGENT));
        LAS unsigned* tl = (LAS unsigned*)(lds + 131072);
        if (tid < MAXTILES) tl[tid] = __hip_atomic_load(TILEE + tid, __ATOMIC_RELAXED, __HIP_MEMORY_SCOPE_AGENT);
        __syncthreads();
        pg8::EpiMoeDown E{(const i32x2*)(ws + WS_META), (bf16*)(ws + WS_YM), (bf16*)(ws + WS_P2), 1.0f / (F8_SH * F8_SWD)};
        {
            pg8::Gemm g{(const bf16*)(ws + WS_ACT1), (const bf16*)(ws + WS_WDT), FFE / 2, FFE / 2, FFE / 2};
            SchedMoe S; S.T.init(128, D / 256, G, bid); S.tile_e = tl; S.astep = (unsigned long long)256 * FFE; S.bstep = (unsigned long long)256 * FFE; S.nN = D / 256;
            pg8::gemm_phase<pg8::EpiMoeDown, SchedMoe, true, true, true>(lds, g, S, E);
        }
        {
            pg8::Gemm g{(const bf16*)(ws + WS_ACT1), (const bf16*)(ws + WS_WDT), FFE / 2, FFE / 2, KQ / 2};
            SchedMoeTail S; S.nq = (ntiles - 128) * 32; S.G = G; S.c = bid; S.tile_e = tl;
            pg8::gemm_phase<pg8::EpiMoeDown, SchedMoeTail, true, true, true>(lds, g, S, E);
        }
    }
    SEAM(14);

    if (IN(15)) for (int rep_ = 0; rep_ < REP15; ++rep_) {
        const bf16* Y0 = (const bf16*)(ws + WS_YM); const bf16* Y1 = Y0 + (size_t)M * D; const bf16* P2b = (const bf16*)(ws + WS_P2);
        auto addbf = [](f32x4& a, f32x4& c, const u32x4 w) {
            a = a + (f32x4){__uint_as_float(w.x << 16), __uint_as_float(w.x & 0xffff0000u), __uint_as_float(w.y << 16), __uint_as_float(w.y & 0xffff0000u)};
            c = c + (f32x4){__uint_as_float(w.z << 16), __uint_as_float(w.z & 0xffff0000u), __uint_as_float(w.w << 16), __uint_as_float(w.w & 0xffff0000u)}; };
        for (int m = gw; m < M; m += NGW) {
            const i32x2 ps = ((const i32x2*)(ws + WS_POS))[m];
            const int pq0 = __builtin_amdgcn_readfirstlane(ps.x), pq1 = __builtin_amdgcn_readfirstlane(ps.y);
            f32x4 v[8]; float s = 0.f;
#pragma unroll
            for (int j = 0; j < 4; ++j) { const size_t o = (size_t)m * D + 8 * lane + 512 * j;
                unpk8(__builtin_nontemporal_load((const GAS u32x4*)(Hh + o)), v[2 * j], v[2 * j + 1]);
                addbf(v[2 * j], v[2 * j + 1], __builtin_nontemporal_load((const GAS u32x4*)(Y0 + o))); addbf(v[2 * j], v[2 * j + 1], __builtin_nontemporal_load((const GAS u32x4*)(Y1 + o))); }
            for (int sl = 0; sl < 2; ++sl) { const int pq = sl ? pq1 : pq0;
                if (pq >= SPLIT_ROW0) {
                    for (int qq = 0; qq < 3; ++qq) { const bf16* pr = P2b + ((size_t)qq * 2048 + (pq - SPLIT_ROW0)) * D + 8 * lane;
#pragma unroll
                        for (int j = 0; j < 4; ++j) addbf(v[2 * j], v[2 * j + 1], *(const GAS u32x4*)(pr + 512 * j)); } } }
#pragma unroll
            for (int j = 0; j < 8; ++j) s += (v[j].x * v[j].x + v[j].y * v[j].y) + (v[j].z * v[j].z + v[j].w * v[j].w);
            const float rsd = rstd_of(wave_sum(s));
#pragma unroll
            for (int j = 0; j < 4; ++j) { const size_t o = (size_t)m * D + 8 * lane + 512 * j; const f32x4 g0 = *(const GAS f32x4*)(p.in[32] + 8 * lane + 512 * j), g1 = *(const GAS f32x4*)(p.in[32] + 8 * lane + 512 * j + 4);
                __builtin_nontemporal_store(v[2 * j] * rsd * g0, (GAS f32x4*)(p.out + o)); __builtin_nontemporal_store(v[2 * j + 1] * rsd * g1, (GAS f32x4*)(p.out + o + 4)); }
        }
    }
#undef IN
#undef SEAM
}

#ifndef MK_N_LAUNCHES
#define MK_N_LAUNCHES 1
#endif
constexpr int N_PHASES = 16;
extern "C" void kernel_launch(void* const* d_in, const int* in_sizes, int n_in, void* d_out, int out_size, void* d_ws, size_t ws_size, hipStream_t stream) {
    static int grid = 0;
    if (grid == 0) {
        if (n_in != 33 || out_size != M * D || ws_size < WS_END) { fprintf(stderr, "kernel_launch: unexpected shapes: n_in %d out %d ws %zu (need %zu)\n", n_in, out_size, ws_size, (size_t)WS_END); grid = -1; return; }
        int dev = 0, cus = 0, per_cu = 0;
        if (hipGetDevice(&dev) != hipSuccess || hipDeviceGetAttribute(&cus, hipDeviceAttributeMultiprocessorCount, dev) != hipSuccess) { grid = -1; return; }
        if (hipFuncSetAttribute((const void*)fwd_kernel, hipFuncAttributeMaxDynamicSharedMemorySize, LDS_BYTES) != hipSuccess) { fprintf(stderr, "kernel_launch: hipFuncSetAttribute failed\n"); grid = -1; return; }
        if (hipOccupancyMaxActiveBlocksPerMultiprocessor(&per_cu, (const void*)fwd_kernel, 512, LDS_BYTES) != hipSuccess || per_cu < 1) { fprintf(stderr, "kernel_launch: occupancy query says %d\n", per_cu); (void)hipGetLastError(); }
        grid = cus;
        if (grid < 2 * BATCH * NH) { fprintf(stderr, "kernel_launch: needs >= 256 CUs (one WKV scan per workgroup), got %d\n", grid); grid = -1; return; }
    }
    if (grid < 0) return;
    (void)hipMemsetAsync((char*)d_ws + WS_CTL, 0, CTL_ZERO_BYTES, stream);
    Params p{};
    for (int i = 0; i < 33; ++i) p.in[i] = (const float*)d_in[i];
    p.out = (float*)d_out; p.ws = (unsigned char*)d_ws;
#if MK_N_LAUNCHES == 1
    p.ph_lo = 0; p.ph_hi = N_PHASES;
    hipLaunchKernelGGL(fwd_kernel, dim3(grid), dim3(512), LDS_BYTES, stream, p);
#else
    for (int k = 0; k < N_PHASES; ++k) { p.ph_lo = k; p.ph_hi = k + 1; hipLaunchKernelGGL(fwd_kernel, dim3(grid), dim3(512), LDS_BYTES, stream, p); }
#endif
}
```

```cpp
#include <hip/hip_runtime.h>
#include <cstdio>

#define GAS __attribute__((address_space(1)))
#define LAS __attribute__((address_space(3)))
typedef unsigned short bf16;
typedef short bf16x8 __attribute__((ext_vector_type(8)));
typedef float f32x2 __attribute__((ext_vector_type(2)));
typedef float f32x4 __attribute__((ext_vector_type(4)));
typedef float f32x16 __attribute__((ext_vector_type(16)));
typedef unsigned u32x2 __attribute__((ext_vector_type(2)));
typedef unsigned u32x4 __attribute__((ext_vector_type(4)));
typedef int i32x4 __attribute__((ext_vector_type(4)));
typedef int i32x2 __attribute__((ext_vector_type(2)));
typedef int i32x8 __attribute__((ext_vector_type(8)));

constexpr int D = 2048, BATCH = 4, SEQ = 4096, M = BATCH * SEQ, NH = 32, HS = 64;
constexpr int FF0 = 5632, FFE = 7168, NE = 8, LOR = 96, LOG = 256;
constexpr float RMS_EPS = 1e-6f, LNX_EPS = 64e-5f;
constexpr int NCHUNK = M / 64;
constexpr int MAXTILES = 2 * M / 256 + NE;
constexpr int MAXROWS = MAXTILES * 256;

constexpr size_t MiB = (size_t)1 << 20;
constexpr size_t WS_CTL = 0, CTL_ZERO_BYTES = 64 * 1024;
constexpr size_t WS_CNT = 1 * MiB;
constexpr size_t WS_TILEE = WS_CNT + 16 * 1024;
constexpr size_t WS_SEL = WS_CNT + 32 * 1024;
constexpr size_t WS_META = WS_SEL + (size_t)M * 16;
constexpr size_t WS_PART = 256 * 1024;
constexpr size_t WS_POS = WS_META + (size_t)MAXROWS * 8;
constexpr size_t WS_POOLT = 2 * MiB;
constexpr size_t WS_FFN1T = 4 * MiB;
constexpr size_t WS_FFN2T = 48 * MiB;
constexpr size_t WS_RKVLOT = 70 * MiB;
constexpr size_t WS_WOT = 97 * MiB;
constexpr size_t WS_DW2T = 105 * MiB;
constexpr size_t WS_AW2T = WS_DW2T + (size_t)2 * 2048 * 96 * 2;
constexpr size_t WS_G2T = 107 * MiB;
constexpr size_t WS_H = 108 * MiB;
constexpr size_t WS_G = 236 * MiB;
constexpr size_t WS_POOLED = WS_G, WS_HN = WS_G + 64 * MiB, WS_ACT0 = WS_G + 128 * MiB;
constexpr size_t WS_MIX = WS_G;
constexpr size_t WS_RKV = WS_G + 384 * MiB;
constexpr size_t WS_LO = WS_G + 576 * MiB;
constexpr size_t WS_EW = WS_G + 600 * MiB;
constexpr size_t WS_AA = WS_G + 728 * MiB;
constexpr size_t WS_GG = WS_G + 856 * MiB;
constexpr size_t WS_Y = WS_G;
constexpr size_t WS_PO = WS_G + 256 * MiB;
constexpr size_t WS_BS = WS_G + 128 * MiB;
constexpr size_t WS_HN2 = WS_G;
constexpr size_t WS_P2 = WS_G;
constexpr int SPLIT_ROW0 = 128 * 256, KQ = FFE / 4;
constexpr size_t WS_AG = WS_G + 64 * MiB;
constexpr size_t WS_WGUT = WS_G + 920 * MiB;
constexpr size_t WS_WDT = WS_G + 1144 * MiB;
constexpr size_t WS_ACT1 = WS_G + 200 * MiB;
constexpr size_t WS_YM = WS_G + 448 * MiB;
constexpr size_t WS_END = WS_WDT + (size_t)NE * FFE * D;
static_assert(WS_AG + (size_t)MAXROWS * D <= WS_ACT1 && WS_ACT1 + (size_t)MAXROWS * FFE <= WS_YM && WS_YM + (size_t)2 * M * D * 2 <= WS_WGUT && WS_WGUT + (size_t)NE * 2 * FFE * D <= WS_WDT, "moe map");
static_assert(WS_EW + (size_t)2 * M * D * 2 <= WS_AA && WS_AA + (size_t)2 * M * D * 2 <= WS_GG && WS_GG + (size_t)M * D * 2 <= WS_WGUT && WS_END <= (size_t)1600 * MiB, "ws map");
static_assert(WS_PART + (size_t)M * 32 <= WS_CNT && WS_POS + (size_t)M * 8 <= WS_POOLT && WS_G2T + (size_t)2048 * 256 * 2 <= WS_H, "ws small map");

constexpr int LDS_BYTES = 147456;
constexpr int MISC_OFF = LDS_BYTES - 256;

__device__ __forceinline__ float bf2f(unsigned short b) { return __uint_as_float(((unsigned)b) << 16); }
typedef __bf16 bf16v2_t __attribute__((ext_vector_type(2)));
__device__ __forceinline__ unsigned cvt_pk_bf16(float lo, float hi) { const f32x2 v = (f32x2){lo, hi}; return __builtin_bit_cast(unsigned, __builtin_convertvector(v, bf16v2_t)); }
__device__ __forceinline__ void unpk8(const u32x4 w, f32x4& a, f32x4& c) {
    a = (f32x4){__uint_as_float(w.x << 16), __uint_as_float(w.x & 0xffff0000u), __uint_as_float(w.y << 16), __uint_as_float(w.y & 0xffff0000u)};
    c = (f32x4){__uint_as_float(w.z << 16), __uint_as_float(w.z & 0xffff0000u), __uint_as_float(w.w << 16), __uint_as_float(w.w & 0xffff0000u)}; }
__device__ __forceinline__ unsigned pk4_fp8(float a, float b, float c, float d) {
    a = fminf(fmaxf(a, -448.f), 448.f); b = fminf(fmaxf(b, -448.f), 448.f); c = fminf(fmaxf(c, -448.f), 448.f); d = fminf(fmaxf(d, -448.f), 448.f);
    int w = 0; w = __builtin_amdgcn_cvt_pk_fp8_f32(a, b, w, false); w = __builtin_amdgcn_cvt_pk_fp8_f32(c, d, w, true); return (unsigned)w; }
constexpr float F8_SA = 32.f, F8_SWU = 1024.f;
constexpr float F8_SH = 8.f, F8_SWD = 4096.f;
constexpr bool FFN_DOWN_FP8 = true;
constexpr float F8_SH0 = 8.f, F8_SWD0 = 4096.f;
template <int CTRL> __device__ __forceinline__ float dppmov(float v) { return __int_as_float(__builtin_amdgcn_update_dpp(0, __float_as_int(v), CTRL, 0xf, 0xf, true)); }
__device__ __forceinline__ float row16_sum(float v) {
    v += dppmov<0xB1>(v);
    v += dppmov<0x4E>(v);
    v += dppmov<0x141>(v);
    v += dppmov<0x140>(v);
    return v;
}
__device__ __forceinline__ float wave_sum(float v) {
    v = row16_sum(v);
    v += __int_as_float(__builtin_amdgcn_update_dpp(0, __float_as_int(v), 0x142, 0xa, 0xf, false));
    v += __int_as_float(__builtin_amdgcn_update_dpp(0, __float_as_int(v), 0x143, 0xc, 0xf, false));
    return __int_as_float(__builtin_amdgcn_readlane(__float_as_int(v), 63));
}
__device__ __forceinline__ float sigmoidf_(float x) { return __builtin_amdgcn_rcpf(1.0f + __expf(-x)); }
#define LDS_WAIT() asm volatile("s_waitcnt lgkmcnt(0)" ::: "memory")
#define VM_WAIT() asm volatile("s_waitcnt vmcnt(0)" ::: "memory")

namespace pg8 {
constexpr int BM = 256, BK = 64, HALF = 128, HTB = HALF * BK * 2, STAGE_BYTES = 8 * HTB, NXCD = 8, WGM = 4;
__host__ __device__ __forceinline__ int lds_byte(int r, int c) { const int st = (r >> 4) * 2 + (c >> 5), rr = r & 15, cc = c & 31, ob = rr * 64 + cc * 2; return st * 1024 + (ob ^ (((ob >> 9) & 1) << 5)); }
__host__ __device__ __forceinline__ void stage_rc(int b, int& R, int& C) { const int st = b / 1024, sb = b % 1024, swz = sb ^ (((sb >> 9) & 1) << 5); R = (st >> 1) * 16 + swz / 64; C = (st & 1) * 32 + (swz % 64) / 2; }
__host__ __device__ __forceinline__ int perm32(int rho) { const int n = rho >> 4, i = rho & 15; return 8 * (i >> 2) + 4 * n + (i & 3); }

struct Unit { int pm, pn, aux; unsigned long long aoff, boff; };
struct Gemm { const bf16* A; const bf16* Bt; int lda, ldb, K; };

struct TileOrder {
    int nM, nN, nwg, G, c, wgm;
    __device__ __forceinline__ void init(int nM_, int nN_, int G_, int c_, int wgm_ = WGM) { nM = nM_; nN = nN_; nwg = nM * nN; G = G_; c = c_; wgm = wgm_; }
    __device__ __forceinline__ bool map(int i, int& pm, int& pn) const {
        const long L = (long)i * G + c; if (L >= nwg) return false;
        int wgid = (int)L; { const int q = nwg / NXCD, r = nwg % NXCD, xcd = wgid % NXCD, off = wgid / NXCD; wgid = (xcd < r ? xcd * (q + 1) : r * (q + 1) + (xcd - r) * q) + off; }
        const int nig = wgm * nN, gid = wgid / nig, fm = gid * wgm, gsz = (nM - fm) < wgm ? (nM - fm) : wgm;
        pm = fm + ((wgid % nig) % gsz); pn = (wgid % nig) / gsz; return true;
    }
};

template <class Epi, class Sched, bool ALIGN_EPI = true, bool SP2 = true, bool FP8 = false>
__device__ __forceinline__ void gemm_phase(LAS unsigned char* lds, const Gemm g, const Sched& S, const Epi& E) {
    const int tid = threadIdx.x, wid = __builtin_amdgcn_readfirstlane(tid >> 6), lane = tid & 63, wr = wid >> 2, wc = wid & 3, fr = lane & 15, fq = lane >> 4;
    const int K = g.K, nt = K / BK;
    unsigned voffA[2], voffB[2];
#pragma unroll
    for (int i = 0; i < 2; ++i) { int R, C; stage_rc(tid * 16 + i * 8192, R, C); const int Rb = Epi::PERM ? ((R & ~31) + perm32(R & 31)) : R;
        voffA[i] = (unsigned)(R * g.lda + C) * 2u; voffB[i] = (unsigned)(Rb * g.ldb + C) * 2u; }
    const size_t kstep = (size_t)(BK * 2);
    const size_t hstepA = (size_t)HALF * g.lda * 2, hstepB = (size_t)HALF * g.ldb * 2;
    const unsigned ldsw = (unsigned)wid * 1024u;
    const int aoff = lds_byte(wr * 64 + fr, fq * 8), boff = lds_byte(wc * 32 + fr, fq * 8);
#define PG8_SA(b, h) (((b) * 2 + (h)) * HTB)
#define PG8_SB(b, h) ((4 + (b) * 2 + (h)) * HTB)
#define PG8_STAGE(bufoff, gbase, voff) do { _Pragma("unroll") for (int _i = 0; _i < 2; ++_i) \
        __builtin_amdgcn_global_load_lds((const unsigned*)((const char*)(gbase) + (voff)[_i]), (LAS unsigned*)(lds + (bufoff) + ldsw + _i * 8192), 16, 0, 0); } while (0)
#define PG8_LD8(off) __builtin_bit_cast(i32x8, __builtin_shufflevector(*(const LAS u32x4*)(lds + (off)), *(const LAS u32x4*)(lds + (off) + 1024), 0, 1, 2, 3, 4, 5, 6, 7))
#define PG8_LDA(dst, b, h) do { if constexpr (FP8) { _Pragma("unroll") for (int m = 0; m < 4; ++m) dst##8[m] = PG8_LD8(PG8_SA(b, h) + aoff + m * 2048); } \
        else { _Pragma("unroll") for (int m = 0; m < 4; ++m) _Pragma("unroll") for (int k = 0; k < 2; ++k) dst[m][k] = *(const LAS bf16x8*)(lds + PG8_SA(b, h) + aoff + m * 2048 + k * 1024); } } while (0)
#define PG8_LDB(dst, b, h) do { if constexpr (FP8) { _Pragma("unroll") for (int n = 0; n < 2; ++n) dst##8[n] = PG8_LD8(PG8_SB(b, h) + boff + n * 2048); } \
        else { _Pragma("unroll") for (int n = 0; n < 2; ++n) _Pragma("unroll") for (int k = 0; k < 2; ++k) dst[n][k] = *(const LAS bf16x8*)(lds + PG8_SB(b, h) + boff + n * 2048 + k * 1024); } } while (0)
#define PG8_MMA(ai, bj, At, Bt) do { __builtin_amdgcn_s_setprio(1); _Pragma("unroll") for (int m = 0; m < 4; ++m) _Pragma("unroll") for (int n = 0; n < 2; ++n) { \
        if constexpr (FP8) asm volatile("v_mfma_scale_f32_16x16x128_f8f6f4 %0, %1, %2, %0, %3, %3 op_sel_hi:[0,0,0]" : "+v"(acc[ai][bj][m][n]) : "v"(Bt##8[n]), "v"(At##8[m]), "v"(f8scale)); \
        else { _Pragma("unroll") for (int k = 0; k < 2; ++k) acc[ai][bj][m][n] = __builtin_amdgcn_mfma_f32_16x16x32_bf16(Bt[n][k], At[m][k], acc[ai][bj][m][n], 0, 0, 0); } } __builtin_amdgcn_s_setprio(0); } while (0)
#define PG8_WAIT_V(n) asm volatile("s_waitcnt vmcnt(" #n ")" ::: "memory")
#define PG8_WAIT_L(n) asm volatile("s_waitcnt lgkmcnt(" #n ")" ::: "memory")
#define PG8_BAR __builtin_amdgcn_s_barrier()
#define PG8_SCHED __builtin_amdgcn_sched_barrier(0)
    Unit cur, nxt; int ui = 0;
    if (!S.next(0, cur)) return;
    f32x4 acc[2][2][4][2];
#pragma unroll
    for (int a = 0; a < 2; ++a)
#pragma unroll
        for (int b = 0; b < 2; ++b)
#pragma unroll
            for (int m = 0; m < 4; ++m)
#pragma unroll
                for (int n = 0; n < 2; ++n) acc[a][b][m][n] = (f32x4){0.f, 0.f, 0.f, 0.f};
    bf16x8 At[4][2], B0[2][2], B1[2][2]; i32x8 At8[4], B08[2], B18[2];
    const int f8scale = 0x7f7f7f7f;
    const char* cA = (const char*)g.A + cur.aoff; const char* cB = (const char*)g.Bt + cur.boff;
    if constexpr (SP2) {
        PG8_STAGE(PG8_SB(0, 0), cB, voffB); PG8_STAGE(PG8_SB(0, 1), cB + hstepB, voffB); PG8_STAGE(PG8_SA(0, 0), cA, voffA); PG8_STAGE(PG8_SA(0, 1), cA + hstepA, voffA);
        if (wr == 1) PG8_BAR;
        PG8_WAIT_V(2); PG8_BAR;
        PG8_STAGE(PG8_SB(1, 0), cB + kstep, voffB); PG8_STAGE(PG8_SA(1, 0), cA + kstep, voffA); PG8_STAGE(PG8_SB(1, 1), cB + hstepB + kstep, voffB);
        PG8_WAIT_V(6); PG8_BAR;
    } else {
        PG8_STAGE(PG8_SB(0, 0), cB, voffB); PG8_STAGE(PG8_SA(0, 0), cA, voffA); PG8_STAGE(PG8_SB(0, 1), cB + hstepB, voffB); PG8_STAGE(PG8_SA(0, 1), cA + hstepA, voffA);
        if (wr == 1) PG8_BAR;
        PG8_WAIT_V(4); PG8_BAR;
        PG8_STAGE(PG8_SB(1, 0), cB + kstep, voffB); PG8_STAGE(PG8_SA(1, 0), cA + kstep, voffA); PG8_STAGE(PG8_SB(1, 1), cB + hstepB + kstep, voffB);
        PG8_WAIT_V(6); PG8_BAR;
    }
    for (;;) {
        const bool has_next = S.next(ui + 1, nxt);
        const char* nA = has_next ? (const char*)g.A + nxt.aoff : cA; const char* nB = has_next ? (const char*)g.Bt + nxt.boff : cB;
        for (int t = 0; t < nt; t += 2) {
            const bool last = (t == nt - 2);
            const char* a1 = cA + (size_t)(t + 1) * kstep;
            const char* a2 = last ? nA : cA + (size_t)(t + 2) * kstep; const char* b2 = last ? nB : cB + (size_t)(t + 2) * kstep;
            const char* a3 = a2 + kstep; const char* b3 = b2 + kstep;
            if constexpr (SP2) {
            PG8_LDB(B0, 0, 0); PG8_LDB(B1, 0, 1); PG8_SCHED; PG8_LDA(At, 0, 0); PG8_STAGE(PG8_SA(1, 1), a1 + hstepA, voffA);
            PG8_WAIT_V(8); PG8_WAIT_L(0); PG8_BAR; PG8_MMA(0, 0, At, B0); PG8_MMA(0, 1, At, B1); PG8_BAR; PG8_SCHED;
            PG8_LDA(At, 0, 1); PG8_STAGE(PG8_SB(0, 0), b2, voffB); PG8_STAGE(PG8_SB(0, 1), b2 + hstepB, voffB); PG8_STAGE(PG8_SA(0, 0), a2, voffA);
            PG8_WAIT_V(8); PG8_WAIT_L(0); PG8_BAR; PG8_MMA(1, 0, At, B0); PG8_MMA(1, 1, At, B1); PG8_BAR; PG8_SCHED;
            PG8_LDB(B0, 1, 0); PG8_LDB(B1, 1, 1); PG8_SCHED; PG8_LDA(At, 1, 0); PG8_STAGE(PG8_SA(0, 1), a2 + hstepA, voffA);
            PG8_WAIT_V(8); PG8_WAIT_L(0); PG8_BAR; PG8_MMA(0, 0, At, B0); PG8_MMA(0, 1, At, B1); PG8_BAR; PG8_SCHED;
            PG8_LDA(At, 1, 1); PG8_STAGE(PG8_SB(1, 0), b3, voffB); PG8_STAGE(PG8_SB(1, 1), b3 + hstepB, voffB); PG8_STAGE(PG8_SA(1, 0), a3, voffA);
            PG8_WAIT_V(8); PG8_WAIT_L(0); PG8_BAR; PG8_MMA(1, 0, At, B0); PG8_MMA(1, 1, At, B1); PG8_BAR; PG8_SCHED;
            } else {
            PG8_LDB(B0, 0, 0); PG8_SCHED; PG8_LDA(At, 0, 0); PG8_STAGE(PG8_SA(1, 1), a1 + hstepA, voffA);
            PG8_WAIT_L(8); PG8_BAR; PG8_WAIT_L(0); PG8_MMA(0, 0, At, B0); PG8_BAR; PG8_SCHED;
            PG8_LDB(B1, 0, 1); PG8_STAGE(PG8_SB(0, 0), b2, voffB);
            PG8_BAR; PG8_WAIT_L(0); PG8_MMA(0, 1, At, B1); PG8_BAR;
            PG8_LDA(At, 0, 1); PG8_STAGE(PG8_SA(0, 0), a2, voffA);
            PG8_BAR; PG8_WAIT_L(0); PG8_MMA(1, 0, At, B0); PG8_BAR; PG8_SCHED;
            PG8_STAGE(PG8_SB(0, 1), b2 + hstepB, voffB);
            PG8_WAIT_V(6); PG8_BAR; PG8_MMA(1, 1, At, B1); PG8_BAR;
            PG8_LDB(B0, 1, 0); PG8_SCHED; PG8_LDA(At, 1, 0); PG8_STAGE(PG8_SA(0, 1), a2 + hstepA, voffA);
            PG8_WAIT_L(8); PG8_BAR; PG8_WAIT_L(0); PG8_MMA(0, 0, At, B0); PG8_BAR; PG8_SCHED;
            PG8_LDB(B1, 1, 1); PG8_STAGE(PG8_SB(1, 0), b3, voffB);
            PG8_BAR; PG8_WAIT_L(0); PG8_MMA(0, 1, At, B1); PG8_BAR;
            PG8_LDA(At, 1, 1); PG8_STAGE(PG8_SA(1, 0), a3, voffA);
            PG8_BAR; PG8_WAIT_L(0); PG8_MMA(1, 0, At, B0); PG8_BAR; PG8_SCHED;
            PG8_STAGE(PG8_SB(1, 1), b3 + hstepB, voffB);
            PG8_WAIT_V(6); PG8_BAR; PG8_MMA(1, 1, At, B1); PG8_BAR;
            }
        }
        if constexpr (ALIGN_EPI) { if (wr == 0) PG8_BAR; }
        if constexpr (FP8) {
            asm volatile("s_nop 15\n\ts_nop 3" ::: "memory");
#pragma unroll
            for (int a = 0; a < 2; ++a)
#pragma unroll
                for (int b = 0; b < 2; ++b)
#pragma unroll
                    for (int m = 0; m < 4; ++m)
#pragma unroll
                        for (int n = 0; n < 2; ++n) asm volatile("" : "+v"(acc[a][b][m][n])); }
        E(acc, cur, wr, wc, fr, fq);
        if (!has_next) break;
#pragma unroll
        for (int a = 0; a < 2; ++a)
#pragma unroll
            for (int b = 0; b < 2; ++b)
#pragma unroll
                for (int m = 0; m < 4; ++m)
#pragma unroll
                    for (int n = 0; n < 2; ++n) acc[a][b][m][n] = (f32x4){0.f, 0.f, 0.f, 0.f};
        cur = nxt; cA = nA; cB = nB; ++ui;
        if constexpr (ALIGN_EPI) { if (wr == 1) PG8_BAR; }
    }
    PG8_WAIT_V(0);
    if constexpr (!ALIGN_EPI) { if (wr == 0) PG8_BAR; }
    PG8_BAR;
#undef PG8_SA
#undef PG8_SB
#undef PG8_STAGE
#undef PG8_LDA
#undef PG8_LDB
#undef PG8_MMA
#undef PG8_LD8
#undef PG8_WAIT_V
#undef PG8_WAIT_L
#undef PG8_BAR
#undef PG8_SCHED
}

struct EpiPool {
    static constexpr bool PERM = true;
    const float* X; bf16* Hh; const float* scale; LAS float* red; float* part;
    __device__ __forceinline__ void operator()(const f32x4 (&acc)[2][2][4][2], const Unit& u, int wr, int wc, int fr, int fq) const {
        const int row0 = u.pm * BM + wr * 64 + fr, col0 = u.pn * BM + wc * 32 + 8 * fq;
        float ss[2][4];
        f32x4 sv[2][2];
#pragma unroll
        for (int bj = 0; bj < 2; ++bj)
#pragma unroll
            for (int n = 0; n < 2; ++n) sv[bj][n] = *(const GAS f32x4*)(scale + col0 + bj * HALF + 4 * n);
#pragma unroll
        for (int ai = 0; ai < 2; ++ai)
#pragma unroll
            for (int m = 0; m < 4; ++m) { const size_t off = (size_t)(row0 + ai * HALF + m * 16) * D + col0; float sq = 0.f;
#pragma unroll
                for (int bj = 0; bj < 2; ++bj) { const f32x4 x0 = __builtin_nontemporal_load((const GAS f32x4*)(X + off + bj * HALF)), x1 = __builtin_nontemporal_load((const GAS f32x4*)(X + off + bj * HALF + 4));
                    const f32x4 v0 = x0 + acc[ai][bj][m][0] * sv[bj][0], v1 = x1 + acc[ai][bj][m][1] * sv[bj][1];
                    const f32x4 q = v0 * v0 + v1 * v1; sq += (q[0] + q[1]) + (q[2] + q[3]);
                    *(GAS u32x4*)(Hh + off + bj * HALF) = (u32x4){cvt_pk_bf16(v0[0], v0[1]), cvt_pk_bf16(v0[2], v0[3]), cvt_pk_bf16(v1[0], v1[1]), cvt_pk_bf16(v1[2], v1[3])}; }
                ss[ai][m] = sq;
                asm volatile("" ::: "memory"); }
#pragma unroll
        for (int ai = 0; ai < 2; ++ai)
#pragma unroll
            for (int m = 0; m < 4; ++m) { float v = ss[ai][m]; v += __shfl_xor(v, 16); v += __shfl_xor(v, 32); if (fq == 0) red[(ai * HALF + wr * 64 + m * 16 + fr) * 4 + wc] = v; }
        __syncthreads();
        { const int t = (int)threadIdx.x; if (t < BM) { const f32x4 r4 = *(LAS f32x4*)(red + t * 4); part[(size_t)(u.pm * BM + t) * 8 + u.pn] = (r4[0] + r4[1]) + (r4[2] + r4[3]); } }
        __syncthreads();
    }
};
struct EpiResid {
    static constexpr bool PERM = true;
    bf16* Hh; float post = 1.0f;
    __device__ __forceinline__ void operator()(const f32x4 (&acc)[2][2][4][2], const Unit& u, int wr, int wc, int fr, int fq) const {
        const int row0 = u.pm * BM + wr * 64 + fr, col0 = u.pn * BM + wc * 32 + 8 * fq;
#pragma unroll
        for (int ai = 0; ai < 2; ++ai)
#pragma unroll
            for (int m = 0; m < 4; ++m) { GAS bf16* rowp = (GAS bf16*)Hh + (size_t)(row0 + ai * HALF + m * 16) * D + col0;
#pragma unroll
                for (int bj = 0; bj < 2; ++bj) { f32x4 h0, h1; unpk8(*(const GAS u32x4*)(rowp + bj * HALF), h0, h1);
                    const f32x4 v0 = h0 + acc[ai][bj][m][0] * post, v1 = h1 + acc[ai][bj][m][1] * post;
                    *(GAS u32x4*)(rowp + bj * HALF) = (u32x4){cvt_pk_bf16(v0[0], v0[1]), cvt_pk_bf16(v0[2], v0[3]), cvt_pk_bf16(v1[0], v1[1]), cvt_pk_bf16(v1[2], v1[3])}; }
                asm volatile("" ::: "memory"); }
    }
};
struct EpiSwiglu {
    static constexpr bool PERM = true;
    bf16* O; int ldo; const float* part;
    __device__ __forceinline__ void operator()(const f32x4 (&acc)[2][2][4][2], const Unit& u, int wr, int wc, int fr, int fq) const {
        const int row0 = u.pm * BM + wr * 64 + fr, col0 = u.pn * HALF + wc * 32 + 8 * fq;
#pragma unroll
        for (int ai = 0; ai < 2; ++ai)
#pragma unroll
            for (int m = 0; m < 4; ++m) {
                float rsv; { const GAS f32x4* pp = (const GAS f32x4*)(part + (size_t)(row0 + ai * HALF + m * 16) * 8); const f32x4 p0 = pp[0], p1 = pp[1]; rsv = 1.0f / sqrtf((((p0[0] + p0[1]) + (p0[2] + p0[3])) + ((p1[0] + p1[1]) + (p1[2] + p1[3]))) * (1.0f / D) + RMS_EPS); }
                float o[8];
#pragma unroll
                for (int n = 0; n < 2; ++n)
#pragma unroll
                    for (int j = 0; j < 4; ++j) { const float gt = acc[ai][0][m][n][j] * rsv, up = acc[ai][1][m][n][j] * rsv; o[4 * n + j] = gt * sigmoidf_(gt) * up; }
                u32x4 w; w.x = cvt_pk_bf16(o[0], o[1]); w.y = cvt_pk_bf16(o[2], o[3]); w.z = cvt_pk_bf16(o[4], o[5]); w.w = cvt_pk_bf16(o[6], o[7]);
                *(GAS u32x4*)(O + (size_t)(row0 + ai * HALF + m * 16) * ldo + col0) = w; }
    }
};
struct EpiSwigluF8 {
    static constexpr bool PERM = true;
    unsigned char* O; int ldo; float pre;
    __device__ __forceinline__ void operator()(const f32x4 (&acc)[2][2][4][2], const Unit& u, int wr, int wc, int fr, int fq) const {
        const int row0 = u.pm * BM + wr * 64 + fr, col0 = u.pn * HALF + wc * 32 + 8 * fq;
        const float c_e = -1.44269504f * pre, c_gu = pre * pre * F8_SH;
#pragma unroll
        for (int ai = 0; ai < 2; ++ai)
#pragma unroll
            for (int m = 0; m < 4; ++m) {
                float o[8];
#pragma unroll
                for (int n = 0; n < 2; ++n)
#pragma unroll
                    for (int j = 0; j < 4; ++j) { const float ga = acc[ai][0][m][n][j], ua = acc[ai][1][m][n][j];
                        const float sg = __builtin_amdgcn_rcpf(1.0f + __builtin_amdgcn_exp2f(ga * c_e));
                        o[4 * n + j] = __builtin_amdgcn_fmed3f(ga * sg * (ua * c_gu), -448.f, 448.f); }
                int w0 = 0, w1 = 0;
                w0 = __builtin_amdgcn_cvt_pk_fp8_f32(o[0], o[1], w0, false); w0 = __builtin_amdgcn_cvt_pk_fp8_f32(o[2], o[3], w0, true);
                w1 = __builtin_amdgcn_cvt_pk_fp8_f32(o[4], o[5], w1, false); w1 = __builtin_amdgcn_cvt_pk_fp8_f32(o[6], o[7], w1, true);
                *(GAS u32x2*)(O + (size_t)(row0 + ai * HALF + m * 16) * ldo + col0) = (u32x2){(unsigned)w0, (unsigned)w1}; }
    }
};
struct EpiSwigluF8R {
    static constexpr bool PERM = true;
    unsigned char* O; int ldo; float osc; const float* part;
    __device__ __forceinline__ void operator()(const f32x4 (&acc)[2][2][4][2], const Unit& u, int wr, int wc, int fr, int fq) const {
        const int row0 = u.pm * BM + wr * 64 + fr, col0 = u.pn * HALF + wc * 32 + 8 * fq;
#pragma unroll
        for (int ai = 0; ai < 2; ++ai)
#pragma unroll
            for (int m = 0; m < 4; ++m) {
                float rsv; { const GAS f32x4* pp = (const GAS f32x4*)(part + (size_t)(row0 + ai * HALF + m * 16) * 8); const f32x4 p0 = pp[0], p1 = pp[1]; rsv = 1.0f / sqrtf((((p0[0] + p0[1]) + (p0[2] + p0[3])) + ((p1[0] + p1[1]) + (p1[2] + p1[3]))) * (1.0f / D) + RMS_EPS); }
                const float c_e = -1.44269504f * rsv, c_gu = rsv * rsv * osc;
                float o[8];
#pragma unroll
                for (int n = 0; n < 2; ++n)
#pragma unroll
                    for (int j = 0; j < 4; ++j) { const float ga = acc[ai][0][m][n][j], ua = acc[ai][1][m][n][j];
                        const float sg = __builtin_amdgcn_rcpf(1.0f + __builtin_amdgcn_exp2f(ga * c_e));
                        o[4 * n + j] = __builtin_amdgcn_fmed3f(ga * sg * (ua * c_gu), -448.f, 448.f); }
                int w0 = 0, w1 = 0;
                w0 = __builtin_amdgcn_cvt_pk_fp8_f32(o[0], o[1], w0, false); w0 = __builtin_amdgcn_cvt_pk_fp8_f32(o[2], o[3], w0, true);
                w1 = __builtin_amdgcn_cvt_pk_fp8_f32(o[4], o[5], w1, false); w1 = __builtin_amdgcn_cvt_pk_fp8_f32(o[6], o[7], w1, true);
                *(GAS u32x2*)(O + (size_t)(row0 + ai * HALF + m * 16) * ldo + col0) = (u32x2){(unsigned)w0, (unsigned)w1}; }
    }
};
struct EpiRkvLo {
    static constexpr bool PERM = true;
    bf16* RKV; bf16* LO;
    __device__ __forceinline__ void operator()(const f32x4 (&acc)[2][2][4][2], const Unit& u, int wr, int wc, int fr, int fq) const {
        const int row0 = u.pm * BM + wr * 64 + fr; const int aux = u.aux;
        bf16* base; int ldo;
        if (aux < 3) { base = RKV + (size_t)aux * M * D + u.pn * BM; ldo = D; } else { base = LO + (size_t)(aux - 3) * M * 256; ldo = 256; }
        base += wc * 32 + 8 * fq;
#pragma unroll
        for (int ai = 0; ai < 2; ++ai)
#pragma unroll
            for (int m = 0; m < 4; ++m) { bf16* rowp = base + (size_t)(row0 + ai * HALF + m * 16) * ldo;
#pragma unroll
                for (int bj = 0; bj < 2; ++bj) { f32x4 v0 = acc[ai][bj][m][0], v1 = acc[ai][bj][m][1];
                    if (aux == 3) {
#pragma unroll
                        for (int j = 0; j < 4; ++j) { v0[j] = 1.0f - 2.0f * __builtin_amdgcn_rcpf(1.0f + __expf(2.0f * v0[j])); v1[j] = 1.0f - 2.0f * __builtin_amdgcn_rcpf(1.0f + __expf(2.0f * v1[j])); } }
                    else if (aux == 5) {
#pragma unroll
                        for (int j = 0; j < 4; ++j) { v0[j] = sigmoidf_(v0[j]); v1[j] = sigmoidf_(v1[j]); } }
                    u32x4 w; w.x = cvt_pk_bf16(v0[0], v0[1]); w.y = cvt_pk_bf16(v0[2], v0[3]); w.z = cvt_pk_bf16(v1[0], v1[1]); w.w = cvt_pk_bf16(v1[2], v1[3]);
                    *(GAS u32x4*)(rowp + bj * HALF) = w; } }
    }
};
struct EpiMoeDown {
    static constexpr bool PERM = true;
    const i32x2* meta; bf16* Y; bf16* P2; float post;
    __device__ __forceinline__ void operator()(const f32x4 (&acc)[2][2][4][2], const Unit& u, int wr, int wc, int fr, int fq) const {
        const int row0 = u.pm * BM + wr * 64 + fr, col0 = u.pn * BM + wc * 32 + 8 * fq;
#pragma unroll
        for (int ai = 0; ai < 2; ++ai)
#pragma unroll
            for (int m = 0; m < 4; ++m) { const i32x2 mt = *(const GAS i32x2*)(meta + row0 + ai * HALF + m * 16);
                if (mt.x >= 0) { const int tok = mt.x & 0x3fff, slot = (mt.x >> 14) & 1; const float gt = __int_as_float(mt.y) * post;
                    GAS bf16* rowp = (u.aux == 0) ? (GAS bf16*)Y + ((size_t)slot * M + tok) * D + col0 : (GAS bf16*)P2 + ((size_t)(u.aux - 1) * 2048 + (row0 + ai * HALF + m * 16 - 32768)) * D + col0;
#pragma unroll
                    for (int bj = 0; bj < 2; ++bj) { const f32x4 v0 = acc[ai][bj][m][0] * gt, v1 = acc[ai][bj][m][1] * gt;
                        *(GAS u32x4*)(rowp + bj * HALF) = (u32x4){cvt_pk_bf16(v0[0], v0[1]), cvt_pk_bf16(v0[2], v0[3]), cvt_pk_bf16(v1[0], v1[1]), cvt_pk_bf16(v1[2], v1[3])}; } } }
    }
};
}

#define XB_TMO      128
#define XB_XCNT(j)  (256  + 64 * (j))
#define XB_XSUB(j)  (1280 + 64 * (j))
#define XB_XGEN(j)  (2304 + 64 * (j))
#define XB_TOP      3328
#define XB_TOPGEN   3392
#define XCD_BAR_WORDS 3456
#define XB_SPIN_CAP (1u << 18)
__device__ __forceinline__ unsigned xb_ld(unsigned* p)              { return __hip_atomic_load(p, __ATOMIC_RELAXED, __HIP_MEMORY_SCOPE_AGENT); }
__device__ __forceinline__ unsigned xb_add(unsigned* p, unsigned v) { return __hip_atomic_fetch_add(p, v, __ATOMIC_RELAXED, __HIP_MEMORY_SCOPE_AGENT); }
__device__ __forceinline__ unsigned xb_xcc_id() { return (unsigned)__builtin_amdgcn_s_getreg((3 << 11) | 20) & 0xFu; }
#define XB_SPIN(cond, bar) do { unsigned _sp = 0; while (cond) { __builtin_amdgcn_s_sleep(1); \
    if ((++_sp & 255u) == 0u) { if (xb_ld(&(bar)[XB_TMO])) break; if (_sp > XB_SPIN_CAP) { atomicAdd(&(bar)[XB_TMO], 1u); break; } } } } while (0)
struct XcdBarrier { unsigned* bar; unsigned x; volatile LAS unsigned* st; };
__device__ __forceinline__ XcdBarrier xcd_barrier_post(unsigned* bar, volatile LAS unsigned* st) {
    XcdBarrier b; b.bar = bar; b.x = xb_xcc_id(); b.st = st;
    if (threadIdx.x == 0) (void)xb_add(&bar[XB_XCNT(b.x)], 1u);
    return b;
}
__device__ __forceinline__ void xcd_barrier_complete(unsigned* bar, unsigned x, unsigned& nloc, unsigned& nx) {
    const unsigned G = gridDim.x * gridDim.y * gridDim.z;
    unsigned sum, cnt, mine, sp = 0u;
    for (;;) {
        sum = 0u; cnt = 0u; mine = 0u;
#pragma unroll
        for (unsigned j = 0; j < 16; ++j) { const unsigned c = xb_ld(&bar[XB_XCNT(j)]); sum += c; cnt += (c > 0u) ? 1u : 0u; mine = (j == x) ? c : mine; }
        if (sum == G) break;
        __builtin_amdgcn_s_sleep(1);
        if ((++sp & 255u) == 0u) { if (xb_ld(&bar[XB_TMO])) break; if (sp > XB_SPIN_CAP) { atomicAdd(&bar[XB_TMO], 1u); break; } }
    }
    nloc = mine > 0u ? mine : 1u; nx = cnt > 0u ? cnt : 1u;
}
__device__ __forceinline__ void xcd_barrier(const XcdBarrier& b) {
    asm volatile("s_waitcnt vmcnt(0)" ::: "memory");
    __syncthreads();
    if (threadIdx.x == 0) {
        unsigned* bar = b.bar;
        __builtin_amdgcn_s_waitcnt(0);
        unsigned nloc = b.st[0], nx = b.st[1];
        if (nloc == 0u) { xcd_barrier_complete(bar, b.x, nloc, nx); b.st[0] = nloc; b.st[1] = nx; }
        const unsigned old = xb_add(&bar[XB_XSUB(b.x)], 1u);
        const unsigned gen = old / nloc;
        if (old + 1u == (gen + 1u) * nloc) {
            __builtin_amdgcn_fence(__ATOMIC_RELEASE, "agent");
            asm volatile("s_waitcnt vmcnt(0)" ::: "memory");
            const unsigned og = xb_add(&bar[XB_TOP], 1u);
            const unsigned tg = og / nx;
            if (og + 1u == (tg + 1u) * nx) xb_add(&bar[XB_TOPGEN], 1u);
            else XB_SPIN(xb_ld(&bar[XB_TOPGEN]) == tg, bar);
            __builtin_amdgcn_fence(__ATOMIC_ACQUIRE, "agent");
            xb_add(&bar[XB_XGEN(b.x)], 1u);
            asm volatile("s_waitcnt vmcnt(0)" ::: "memory");
        } else {
            XB_SPIN(xb_ld(&bar[XB_XGEN(b.x)]) == gen, bar);
            __builtin_amdgcn_fence(__ATOMIC_ACQUIRE, "agent");
            asm volatile("s_waitcnt vmcnt(0)" ::: "memory");
        }
    }
    __syncthreads();
}

struct SchedPlain {
    pg8::TileOrder T; unsigned long long astep, bstep;
    __device__ __forceinline__ bool next(int i, pg8::Unit& u) const { int pm, pn; if (!T.map(i, pm, pn)) return false; u.pm = pm; u.pn = pn; u.aux = 0; u.aoff = (unsigned long long)pm * astep; u.boff = (unsigned long long)pn * bstep; return true; }
};
struct SchedPool {
    pg8::TileOrder T;
    __device__ __forceinline__ bool next(int i, pg8::Unit& u) const { int pm, pn; if (!T.map(i, pm, pn)) return false; u.pm = pm; u.pn = pn; u.aux = 0;
        u.aoff = (unsigned long long)pm * 256 * D * 2 + (unsigned long long)(pn >> 1) * 512 * 2; u.boff = (unsigned long long)pn * 256 * 512 * 2; return true; }
};
struct SchedRkvLo {
    pg8::TileOrder T;
    __device__ __forceinline__ bool next(int i, pg8::Unit& u) const { int pm, pn; if (!T.map(i, pm, pn)) return false; u.pm = pm;
        int amat;
        if (pn < 24) { const int w = pn >> 3; u.aux = w; u.pn = pn & 7; amat = (w == 0) ? 0 : (w == 1 ? 2 : 3); }
        else { const int q = pn - 24; u.aux = 3 + q; u.pn = 0; amat = (q == 0) ? 1 : (q == 1 ? 4 : 5); }
        u.aoff = ((unsigned long long)amat * M + (unsigned long long)pm * 256) * D * 2; u.boff = (unsigned long long)pn * 256 * D * 2; return true; }
};
struct SchedMoe {
    pg8::TileOrder T; const LAS unsigned* tile_e; unsigned long long astep, bstep; int nN;
    __device__ __forceinline__ bool next(int i, pg8::Unit& u) const { int pm, pn; if (!T.map(i, pm, pn)) return false; u.pm = pm; u.pn = pn; u.aux = 0;
        const int e = (int)__builtin_amdgcn_readfirstlane(tile_e[pm]) & 7;
        u.aoff = (unsigned long long)pm * astep; u.boff = (unsigned long long)(e * nN + pn) * bstep; return true; }
};

constexpr int REP3 = 1, REP6 = 1, REP7 = 1, REP8 = 1, REP9 = 1, REP11 = 1, REP13 = 1, REP14 = 1, REP0 = 1, REP2 = 1, REP5 = 1, REP12 = 1, REP15 = 1;
struct SchedMoeTail {
    int nq, G, c; const LAS unsigned* tile_e;
    __device__ __forceinline__ bool next(int i, pg8::Unit& u) const { const int L = i * G + c; if (L >= nq) return false; const int kq = L & 3, uu = L >> 2, pm = 128 + (uu >> 3), pn = uu & 7;
        const int e = (int)__builtin_amdgcn_readfirstlane(tile_e[pm]) & 7;
        u.pm = pm; u.pn = pn; u.aux = kq; u.aoff = (unsigned long long)pm * 256 * FFE + (unsigned long long)kq * KQ; u.boff = (unsigned long long)(e * 8 + pn) * 256 * FFE + (unsigned long long)kq * KQ; return true; }
};
struct Params { const float* in[33]; float* out; unsigned char* ws; int ph_lo, ph_hi; };

template <bool NTS = false>
__device__ __forceinline__ void tr_tile(const float* W, int N, int k0, int n0, bf16* WT, size_t drow0, int ldd, LAS float* scr, int lane, const float* kscale = nullptr) {
    const int kq = lane >> 4, n4 = (lane & 15) * 4;
    f32x4 v[16];
#pragma unroll
    for (int i = 0; i < 16; ++i) v[i] = __builtin_nontemporal_load((const GAS f32x4*)(W + (size_t)(k0 + 4 * i + kq) * N + n0 + n4));
    if (kscale) {
#pragma unroll
        for (int i = 0; i < 16; ++i) v[i] = v[i] * kscale[k0 + 4 * i + kq]; }
#pragma unroll
    for (int i = 0; i < 16; ++i) { LAS float* s = scr + (4 * i + kq) * 65 + n4; s[0] = v[i].x; s[1] = v[i].y; s[2] = v[i].z; s[3] = v[i].w; }
    LDS_WAIT(); asm volatile("" ::: "memory");
    const int c = lane & 7;
#pragma unroll
    for (int p = 0; p < 8; ++p) { const int n = (lane >> 3) + 8 * p; const LAS float* s = scr + (8 * c) * 65 + n;
        u32x4 o; o.x = cvt_pk_bf16(s[0], s[65]); o.y = cvt_pk_bf16(s[2 * 65], s[3 * 65]); o.z = cvt_pk_bf16(s[4 * 65], s[5 * 65]); o.w = cvt_pk_bf16(s[6 * 65], s[7 * 65]);
        if (NTS) __builtin_nontemporal_store(o, (GAS u32x4*)(WT + (drow0 + n) * ldd + k0 + 8 * c)); else *(GAS u32x4*)(WT + (drow0 + n) * ldd + k0 + 8 * c) = o; }
    LDS_WAIT(); asm volatile("" ::: "memory");
}
__device__ __forceinline__ void cv8_load(const float* W, int N, int k0, int n0, f32x4 (&v)[16], int lane) {
    const int kq = lane >> 4, n4 = (lane & 15) * 4;
#pragma unroll
    for (int i = 0; i < 16; ++i) v[i] = __builtin_nontemporal_load((const GAS f32x4*)(W + (size_t)(k0 + 16 * kq + i) * N + n0 + n4));
}
__device__ __forceinline__ void cv8_store(const f32x4 (&v)[16], int k0, unsigned char* WT, size_t drow0, int ldd, float sc, int lane) {
    const int kq = lane >> 4, n4 = (lane & 15) * 4;
#pragma unroll
    for (int e = 0; e < 4; ++e) { u32x4 o;
#pragma unroll
        for (int d = 0; d < 4; ++d) { int w = 0;
            w = __builtin_amdgcn_cvt_pk_fp8_f32(__builtin_amdgcn_fmed3f(v[4 * d][e] * sc, -448.f, 448.f), __builtin_amdgcn_fmed3f(v[4 * d + 1][e] * sc, -448.f, 448.f), w, false);
            w = __builtin_amdgcn_cvt_pk_fp8_f32(__builtin_amdgcn_fmed3f(v[4 * d + 2][e] * sc, -448.f, 448.f), __builtin_amdgcn_fmed3f(v[4 * d + 3][e] * sc, -448.f, 448.f), w, true);
            o[d] = (unsigned)w; }
        __builtin_nontemporal_store(o, (GAS u32x4*)(WT + (drow0 + n4 + e) * ldd + k0 + 16 * kq)); }
}
constexpr int MOE_T_E = 32 * 112, MOE_NT = NE * 3 * MOE_T_E;
__device__ __forceinline__ void moe_cvh_load(const float* const* in, int it, int h, f32x2 (&v)[16], int lane) {
    const int e = it / (3 * MOE_T_E), r3 = it % (3 * MOE_T_E), which = r3 / MOE_T_E, t = r3 % MOE_T_E;
    const int kq = lane >> 4, n2 = (lane & 15) * 2 + 32 * h;
    const float* W; int N, k0, n0;
    if (which < 2) { W = in[29 + which] + (size_t)e * D * FFE; N = FFE; k0 = 64 * (t / 112); n0 = 64 * (t % 112); } else { W = in[31] + (size_t)e * FFE * D; N = D; k0 = 64 * (t / 32); n0 = 64 * (t % 32); }
#pragma unroll
    for (int i = 0; i < 16; ++i) v[i] = __builtin_nontemporal_load((const GAS f32x2*)(W + (size_t)(k0 + 16 * kq + i) * N + n0 + n2));
}
__device__ __forceinline__ void moe_cvh_store(unsigned char* ws, int it, int h, const f32x2 (&v)[16], int lane) {
    const int e = it / (3 * MOE_T_E), r3 = it % (3 * MOE_T_E), which = r3 / MOE_T_E, t = r3 % MOE_T_E;
    const int kq = lane >> 4, n2 = (lane & 15) * 2 + 32 * h;
    unsigned char* WT; size_t drow0; int ldd, k0; float sc;
    if (which < 2) { const int nb2 = t % 112; WT = ws + WS_WGUT; drow0 = (size_t)e * 2 * FFE + (size_t)((64 * nb2) >> 7) * 256 + 128 * which + ((64 * nb2) & 127); ldd = D; k0 = 64 * (t / 112); sc = F8_SWU; }
    else { WT = ws + WS_WDT; drow0 = (size_t)e * D + 64 * (t % 32); ldd = FFE; k0 = 64 * (t / 32); sc = F8_SWD; }
#pragma unroll
    for (int e2 = 0; e2 < 2; ++e2) { u32x4 o;
#pragma unroll
        for (int d = 0; d < 4; ++d) { int w = 0;
            w = __builtin_amdgcn_cvt_pk_fp8_f32(__builtin_amdgcn_fmed3f(v[4 * d][e2] * sc, -448.f, 448.f), __builtin_amdgcn_fmed3f(v[4 * d + 1][e2] * sc, -448.f, 448.f), w, false);
            w = __builtin_amdgcn_cvt_pk_fp8_f32(__builtin_amdgcn_fmed3f(v[4 * d + 2][e2] * sc, -448.f, 448.f), __builtin_amdgcn_fmed3f(v[4 * d + 3][e2] * sc, -448.f, 448.f), w, true);
            o[d] = (unsigned)w; }
        __builtin_nontemporal_store(o, (GAS u32x4*)(WT + (drow0 + n2 + e2) * ldd + k0 + 16 * kq)); }
}
constexpr int CVW0 = 4, NCW = 8 - CVW0, MOE_CV_EARLY = (SEQ / 64) * NCW * 256;
constexpr int MOE_CV_HALVES = 2 * (MOE_NT - MOE_CV_EARLY);
static_assert(MOE_CV_HALVES <= (SEQ / 64) * 3 * 256, "half-item slots");
static_assert(MOE_CV_EARLY <= MOE_NT && 2 * BATCH * NH == 256, "early weight-copy items are indexed by the 256 scan workgroups");
__device__ __forceinline__ void moe_cv_load(const float* const* in, int it, f32x4 (&v)[16], int lane) {
    const int e = it / (3 * MOE_T_E), r3 = it % (3 * MOE_T_E), which = r3 / MOE_T_E, t = r3 % MOE_T_E;
    if (which < 2) cv8_load(in[29 + which] + (size_t)e * D * FFE, FFE, 64 * (t / 112), 64 * (t % 112), v, lane);
    else cv8_load(in[31] + (size_t)e * FFE * D, D, 64 * (t / 32), 64 * (t % 32), v, lane);
}
__device__ __forceinline__ void moe_cv_store(unsigned char* ws, int it, const f32x4 (&v)[16], int lane) {
    const int e = it / (3 * MOE_T_E), r3 = it % (3 * MOE_T_E), which = r3 / MOE_T_E, t = r3 % MOE_T_E;
    if (which < 2) { const int nb2 = t % 112; cv8_store(v, 64 * (t / 112), ws + WS_WGUT, (size_t)e * 2 * FFE + (size_t)((64 * nb2) >> 7) * 256 + 128 * which + ((64 * nb2) & 127), D, F8_SWU, lane); }
    else cv8_store(v, 64 * (t / 32), ws + WS_WDT, (size_t)e * D + 64 * (t % 32), FFE, F8_SWD, lane);
}
__device__ __forceinline__ void tr_f8_load(const float* W, int N, int k0, int n0, f32x4 (&v)[16], int lane) {
    const int kq = lane >> 4, n4 = (lane & 15) * 4;
#pragma unroll
    for (int i = 0; i < 16; ++i) v[i] = __builtin_nontemporal_load((const GAS f32x4*)(W + (size_t)(k0 + 4 * i + kq) * N + n0 + n4));
}
__device__ __forceinline__ void tr_f8_store(const f32x4 (&v)[16], int k0, unsigned char* WT, size_t drow0, int ldd, float sc, LAS float* scr, int lane) {
    const int kq = lane >> 4, n4 = (lane & 15) * 4;
#pragma unroll
    for (int i = 0; i < 16; ++i) { LAS float* s = scr + (4 * i + kq) * 65 + n4; s[0] = v[i].x; s[1] = v[i].y; s[2] = v[i].z; s[3] = v[i].w; }
    LDS_WAIT(); asm volatile("" ::: "memory");
    const int c = lane & 3;
#pragma unroll
    for (int p = 0; p < 4; ++p) { const int n = (lane >> 2) + 16 * p; const LAS float* s = scr + (16 * c) * 65 + n;
        u32x4 o;
#pragma unroll
        for (int d = 0; d < 4; ++d) o[d] = pk4_fp8(s[(4 * d) * 65] * sc, s[(4 * d + 1) * 65] * sc, s[(4 * d + 2) * 65] * sc, s[(4 * d + 3) * 65] * sc);
        __builtin_nontemporal_store(o, (GAS u32x4*)(WT + (drow0 + n) * ldd + k0 + 16 * c)); }
    LDS_WAIT(); asm volatile("" ::: "memory");
}
__device__ __forceinline__ void tr_tile32(const float* W, int N, int k0, int n0, bf16* WT, size_t drow0, int ldd, LAS float* scr, int lane) {
    float v[16];
#pragma unroll
    for (int i = 0; i < 16; ++i) v[i] = W[(size_t)(k0 + 2 * i + (lane >> 5)) * N + n0 + (lane & 31)];
#pragma unroll
    for (int i = 0; i < 16; ++i) scr[(2 * i + (lane >> 5)) * 33 + (lane & 31)] = v[i];
    LDS_WAIT(); asm volatile("" ::: "memory");
    const int n = lane & 31, hf = lane >> 5; const LAS float* s = scr + (16 * hf) * 33 + n;
    u32x4 o0, o1;
#pragma unroll
    for (int d = 0; d < 4; ++d) { o0[d] = cvt_pk_bf16(s[(2 * d) * 33], s[(2 * d + 1) * 33]); o1[d] = cvt_pk_bf16(s[(8 + 2 * d) * 33], s[(9 + 2 * d) * 33]); }
    GAS u32x4* dst = (GAS u32x4*)(WT + (drow0 + n) * ldd + k0 + 16 * hf); dst[0] = o0; dst[1] = o1;
    LDS_WAIT(); asm volatile("" ::: "memory");
}

__device__ __forceinline__ float row_sumsq(const float* xr, int lane) {
    const GAS f32x4* p = (const GAS f32x4*)xr + lane; float s = 0.f;
#pragma unroll
    for (int j = 0; j < 8; ++j) { const f32x4 v = p[64 * j]; s += (v.x * v.x + v.y * v.y) + (v.z * v.z + v.w * v.w); }
    return wave_sum(s);
}
__device__ __forceinline__ float row_sumsq_b(const bf16* xr, int lane) {
    float s = 0.f;
#pragma unroll
    for (int j = 0; j < 4; ++j) { f32x4 a, c; unpk8(*(const GAS u32x4*)(xr + 8 * lane + 512 * j), a, c); s += ((a.x * a.x + a.y * a.y) + (a.z * a.z + a.w * a.w)) + ((c.x * c.x + c.y * c.y) + (c.z * c.z + c.w * c.w)); }
    return wave_sum(s);
}
__device__ __forceinline__ float rstd_of(float ss) { return 1.0f / sqrtf(ss * (1.0f / D) + RMS_EPS); }

__device__ __forceinline__ void rms_row_bf16(const float* xr, const float* gamma, bf16* orow, int lane) {
    f32x4 v[8]; float s = 0.f;
#pragma unroll
    for (int j = 0; j < 4; ++j) { v[2 * j] = __builtin_nontemporal_load((const GAS f32x4*)(xr + 8 * lane + 512 * j)); v[2 * j + 1] = __builtin_nontemporal_load((const GAS f32x4*)(xr + 8 * lane + 512 * j + 4)); }
#pragma unroll
    for (int j = 0; j < 8; ++j) s += (v[j].x * v[j].x + v[j].y * v[j].y) + (v[j].z * v[j].z + v[j].w * v[j].w);
    const float rs = rstd_of(wave_sum(s));
#pragma unroll
    for (int j = 0; j < 4; ++j) { const f32x4 g0 = *(const GAS f32x4*)(gamma + 8 * lane + 512 * j), g1 = *(const GAS f32x4*)(gamma + 8 * lane + 512 * j + 4);
        const f32x4 a = v[2 * j] * rs * g0, c = v[2 * j + 1] * rs * g1;
        *(GAS u32x4*)(orow + 8 * lane + 512 * j) = (u32x4){cvt_pk_bf16(a.x, a.y), cvt_pk_bf16(a.z, a.w), cvt_pk_bf16(c.x, c.y), cvt_pk_bf16(c.z, c.w)}; }
}

__device__ __forceinline__ void rms_row_bf16_b(const bf16* xr, const float* gamma, bf16* orow, int lane) {
    f32x4 v[8]; float s = 0.f;
#pragma unroll
    for (int j = 0; j < 4; ++j) unpk8(__builtin_nontemporal_load((const GAS u32x4*)(xr + 8 * lane + 512 * j)), v[2 * j], v[2 * j + 1]);
#pragma unroll
    for (int j = 0; j < 8; ++j) s += (v[j].x * v[j].x + v[j].y * v[j].y) + (v[j].z * v[j].z + v[j].w * v[j].w);
    const float rs = rstd_of(wave_sum(s));
#pragma unroll
    for (int j = 0; j < 4; ++j) { const f32x4 g0 = *(const GAS f32x4*)(gamma + 8 * lane + 512 * j), g1 = *(const GAS f32x4*)(gamma + 8 * lane + 512 * j + 4);
        const f32x4 a = v[2 * j] * rs * g0, c = v[2 * j + 1] * rs * g1;
        *(GAS u32x4*)(orow + 8 * lane + 512 * j) = (u32x4){cvt_pk_bf16(a.x, a.y), cvt_pk_bf16(a.z, a.w), cvt_pk_bf16(c.x, c.y), cvt_pk_bf16(c.z, c.w)}; }
}

template <int MODE>
__device__ __forceinline__ void lora_up_item(const bf16* A, int lda, const bf16* Bt, const float* bias, bf16* out, int m0, int n0, int lane, LAS unsigned char* stg) {
    constexpr int KS = 6;
    const int r = lane & 31, hh = lane >> 5;
    bf16x8 af[KS];
#pragma unroll
    for (int s = 0; s < KS; ++s) af[s] = *(const GAS bf16x8*)(A + (size_t)(m0 + r) * lda + 16 * s + 8 * hh);
    bf16x8 bcur[KS]; f32x4 bvc[4];
#pragma unroll
    for (int s = 0; s < KS; ++s) bcur[s] = *(const GAS bf16x8*)(Bt + (size_t)(n0 + r) * (16 * KS) + 16 * s + 8 * hh);
#pragma unroll
    for (int g4 = 0; g4 < 4; ++g4) bvc[g4] = *(const GAS f32x4*)(bias + n0 + 8 * g4 + 4 * hh);
    for (int ct = 0; ct < 16; ++ct) {
        const int nb = n0 + 32 * ct, nn = n0 + 32 * ((ct < 15) ? ct + 1 : ct);
        bf16x8 bnx[KS]; f32x4 bvn[4];
#pragma unroll
        for (int s = 0; s < KS; ++s) bnx[s] = *(const GAS bf16x8*)(Bt + (size_t)(nn + r) * (16 * KS) + 16 * s + 8 * hh);
#pragma unroll
        for (int g4 = 0; g4 < 4; ++g4) bvn[g4] = *(const GAS f32x4*)(bias + nn + 8 * g4 + 4 * hh);
        f32x16 acc;
#pragma unroll
        for (int i = 0; i < 16; ++i) acc[i] = 0.f;
#pragma unroll
        for (int s = 0; s < KS; ++s) acc = __builtin_amdgcn_mfma_f32_32x32x16_bf16(bcur[s], af[s], acc, 0, 0, 0);
#pragma unroll
        for (int g4 = 0; g4 < 4; ++g4) { f32x4 v = (f32x4){acc[4 * g4], acc[4 * g4 + 1], acc[4 * g4 + 2], acc[4 * g4 + 3]} + bvc[g4];
#pragma unroll
            for (int j = 0; j < 4; ++j) v[j] = sigmoidf_(v[j]) * (MODE == 0 ? 0.60653066f : 1.0f);
            *(LAS u32x2*)(stg + r * 144 + ((ct & 1) * 32 + 8 * g4 + 4 * hh) * 2) = (u32x2){cvt_pk_bf16(v[0], v[1]), cvt_pk_bf16(v[2], v[3])}; }
        if (ct & 1) {
            LDS_WAIT(); asm volatile("" ::: "memory");
#pragma unroll
            for (int ps = 0; ps < 4; ++ps) { const int row = (lane >> 3) + 8 * ps, ch = lane & 7;
                const u32x4 w = *(const LAS u32x4*)(stg + row * 144 + ch * 16);
                __builtin_nontemporal_store(w, (GAS u32x4*)(out + (size_t)(m0 + row) * D + nb - 32 + 8 * ch)); }
            LDS_WAIT(); asm volatile("" ::: "memory"); }
#pragma unroll
        for (int s = 0; s < KS; ++s) bcur[s] = bnx[s];
#pragma unroll
        for (int g4 = 0; g4 < 4; ++g4) bvc[g4] = bvn[g4];
    }
}

__device__ __forceinline__ void lora_up_item_k256(const bf16* A, const bf16* Bt, bf16* out, int m0, int n0, int lane, LAS unsigned char* stg) {
    const int r = lane & 31, hh = lane >> 5;
    bf16x8 af[16];
#pragma unroll
    for (int s = 0; s < 16; ++s) af[s] = *(const GAS bf16x8*)(A + (size_t)(m0 + r) * 256 + 16 * s + 8 * hh);
    bf16x8 bcur[8];
#pragma unroll
    for (int s = 0; s < 8; ++s) bcur[s] = *(const GAS bf16x8*)(Bt + (size_t)(n0 + r) * 256 + 16 * s + 8 * hh);
    f32x16 acc;
    for (int hs = 0; hs < 32; ++hs) {
        const int ct = hs >> 1, kh = hs & 1, nb = n0 + 32 * ct;
        const int hn = (hs < 31) ? hs + 1 : hs; const int nn = n0 + 32 * (hn >> 1), kn = hn & 1;
        bf16x8 bnx[8];
#pragma unroll
        for (int s = 0; s < 8; ++s) bnx[s] = *(const GAS bf16x8*)(Bt + (size_t)(nn + r) * 256 + 128 * kn + 16 * s + 8 * hh);
        if (kh == 0) {
#pragma unroll
            for (int i = 0; i < 16; ++i) acc[i] = 0.f;
#pragma unroll
            for (int s = 0; s < 8; ++s) acc = __builtin_amdgcn_mfma_f32_32x32x16_bf16(bcur[s], af[s], acc, 0, 0, 0);
        } else {
#pragma unroll
            for (int s = 0; s < 8; ++s) acc = __builtin_amdgcn_mfma_f32_32x32x16_bf16(bcur[s], af[8 + s], acc, 0, 0, 0);
#pragma unroll
            for (int g4 = 0; g4 < 4; ++g4)
                *(LAS u32x2*)(stg + r * 144 + ((ct & 1) * 32 + 8 * g4 + 4 * hh) * 2) = (u32x2){cvt_pk_bf16(acc[4 * g4], acc[4 * g4 + 1]), cvt_pk_bf16(acc[4 * g4 + 2], acc[4 * g4 + 3])};
            if (ct & 1) {
                LDS_WAIT(); asm volatile("" ::: "memory");
#pragma unroll
                for (int ps = 0; ps < 4; ++ps) { const int row = (lane >> 3) + 8 * ps, ch = lane & 7;
                    const u32x4 w = *(const LAS u32x4*)(stg + row * 144 + ch * 16);
                    __builtin_nontemporal_store(w, (GAS u32x4*)(out + (size_t)(m0 + row) * D + nb - 32 + 8 * ch)); }
                LDS_WAIT(); asm volatile("" ::: "memory"); }
        }
#pragma unroll
        for (int s = 0; s < 8; ++s) bcur[s] = bnx[s];
    }
}

__global__ void __launch_bounds__(512, 2) fwd_kernel(Params p) {
    extern __shared__ __attribute__((aligned(16))) unsigned char lds_raw[];
    LAS unsigned char* lds = (LAS unsigned char*)lds_raw;
    volatile LAS unsigned* MISC = (volatile LAS unsigned*)(lds + MISC_OFF);
    const int tid = threadIdx.x, lane = tid & 63, wave = __builtin_amdgcn_readfirstlane(tid >> 6);
    const int G = gridDim.x, bid = blockIdx.x;
    const int gw = bid * 8 + wave, NGW = G * 8;
    unsigned char* ws = p.ws;
    if (tid < 64) MISC[tid] = 0u;
    __syncthreads();
    const XcdBarrier bar = xcd_barrier_post((unsigned*)(ws + WS_CTL) + 4096, MISC);
    const int lo = p.ph_lo, hi = p.ph_hi;
#define IN(k) (lo <= (k) && (k) < hi)
#define SEAM(k) do { if (IN(k) && IN((k) + 1)) xcd_barrier(bar); } while (0)

    const float* x = p.in[0];
    bf16* Hh = (bf16*)(ws + WS_H);

    if (IN(0)) for (int rep_ = 0; rep_ < REP0; ++rep_) {
        LAS float* scr = (LAS float*)lds + wave * (64 * 65);
        constexpr int T_POOL = 4 * 64, T_FFN = 32 * 88, T_SQ = 32 * 32, T_G1 = 32 * 4;
        constexpr int NT0 = T_POOL + 3 * T_FFN + 4 * T_SQ + T_G1;
        for (int it = gw; it < NT0; it += NGW) {
            int r = it; const float* W; int N, kb, nb; bf16* WT; size_t drow; int ldd; const float* ksc = nullptr;
            if (r < T_POOL) { const int g = r >> 6, t = r & 63; W = p.in[2] + (size_t)g * 512 * 512; N = 512; kb = t >> 3; nb = t & 7; WT = (bf16*)(ws + WS_POOLT); drow = (size_t)g * 512 + 64 * nb; ldd = 512; }
            else if ((r -= T_POOL) < T_FFN) { W = p.in[5]; N = FF0; kb = r / 88; nb = r % 88; WT = (bf16*)(ws + WS_FFN1T); drow = (size_t)((64 * nb) >> 7) * 256 + ((64 * nb) & 127); ldd = D; ksc = p.in[4]; }
            else if ((r -= T_FFN) < T_FFN) { W = p.in[6]; N = FF0; kb = r / 88; nb = r % 88; WT = (bf16*)(ws + WS_FFN1T); drow = (size_t)((64 * nb) >> 7) * 256 + 128 + ((64 * nb) & 127); ldd = D; ksc = p.in[4]; }
            else if ((r -= T_FFN) < T_FFN) {
                if constexpr (FFN_DOWN_FP8) { f32x4 v8[16]; cv8_load(p.in[7], D, 64 * (r / 32), 64 * (r % 32), v8, lane); cv8_store(v8, 64 * (r / 32), ws + WS_FFN2T, (size_t)64 * (r % 32), FF0, F8_SWD0, lane); continue; }
                else { W = p.in[7]; N = D; kb = r / 32; nb = r % 32; WT = (bf16*)(ws + WS_FFN2T); drow = 64 * nb; ldd = FF0; } }
            else if ((r -= T_FFN) < 3 * T_SQ) { const int w = r / T_SQ, t = r % T_SQ; W = p.in[10 + w]; N = D; kb = t / 32; nb = t % 32; WT = (bf16*)(ws + WS_RKVLOT); drow = (size_t)w * D + 64 * nb; ldd = D; }
            else if ((r -= 3 * T_SQ) < T_SQ) { W = p.in[13]; N = D; kb = r / 32; nb = r % 32; WT = (bf16*)(ws + WS_WOT); drow = 64 * nb; ldd = D; }
            else { r -= T_SQ; W = p.in[20]; N = LOG; kb = r / 4; nb = r % 4; WT = (bf16*)(ws + WS_RKVLOT); drow = (size_t)6656 + 64 * nb; ldd = D; }
            tr_tile(W, N, 64 * kb, 64 * nb, WT, drow, ldd, scr, lane, ksc);
        }
        {
            LAS float* scr32 = (LAS float*)lds + wave * (64 * 65);
            bf16* RK = (bf16*)(ws + WS_RKVLOT);
            for (int it = gw; it < 2048; it += NGW) {
                if (it < 768) { const int q = it / 384, r = it % 384, e = r / 192, t = r % 192, kb = t / 3, nb = t % 3;
                    tr_tile32(p.in[q ? 18 : 15] + (size_t)e * D * LOR, LOR, 32 * kb, 32 * nb, RK, (size_t)(q ? 6400 : 6144) + 96 * e + 32 * nb, D, scr32, lane); }
                else if (it < 1536) { const int r0_ = it - 768, q = r0_ / 384, r = r0_ % 384, e = r / 192, t = r % 192, kb = t / 64, nb = t % 64;
                    tr_tile32(p.in[q ? 19 : 16] + (size_t)e * LOR * D, D, 32 * kb, 32 * nb, (bf16*)(ws + (q ? WS_AW2T : WS_DW2T)), (size_t)e * D + 32 * nb, LOR, scr32, lane); }
                else { const int t = it - 1536, kb = t / 64, nb = t % 64;
                    tr_tile32(p.in[21], D, 32 * kb, 32 * nb, (bf16*)(ws + WS_G2T), (size_t)32 * nb, LOG, scr32, lane); }
            }
            const int gt = bid * 512 + tid, GT = G * 512;
            for (int i = gt; i < 64 * D; i += GT) { RK[(size_t)(6144 + 192) * D + i] = 0; RK[(size_t)(6400 + 192) * D + i] = 0; }
        }
        __syncthreads();
        LAS float* rs = (LAS float*)lds;
        bf16* PO = (bf16*)(ws + WS_POOLED);
        for (int chunk = bid; chunk < NCHUNK; chunk += G) {
            const int r0 = chunk * 64, blo = (r0 / SEQ) * SEQ, bhi = blo + SEQ;
            for (int i = 0; i < 10; ++i) { const int rr = r0 - 8 + wave * 10 + i; if (rr >= blo && rr < bhi) { const float ss = row_sumsq(x + (size_t)rr * D, lane); if (lane == 0) rs[wave * 10 + i] = rstd_of(ss); } }
            __syncthreads();
            const int hf = tid >> 8, c = 8 * (tid & 255), Wh = 1 << ((tid & 255) >> 6);
            const f32x4 gam0 = *(const GAS f32x4*)(p.in[1] + c), gam1 = *(const GAS f32x4*)(p.in[1] + c + 4);
            const int rbeg = r0 + 32 * hf;
            f32x4 s0 = (f32x4){0.f, 0.f, 0.f, 0.f}, s1 = s0;
            for (int rr = max(rbeg - Wh, blo); rr < min(rbeg + Wh, bhi); ++rr) { const float sc = rs[rr - (r0 - 8)]; s0 = s0 + *(const GAS f32x4*)(x + (size_t)rr * D + c) * sc; s1 = s1 + *(const GAS f32x4*)(x + (size_t)rr * D + c + 4) * sc; }
            for (int t = 0; t < 32; ++t) { const int row = rbeg + t; const int s_lo = max(row - Wh, blo), s_hi = min(row + Wh, bhi);
                const float sc = rs[row - (r0 - 8)], inv = 1.0f / (float)(s_hi - s_lo);
                const f32x4 c0 = *(const GAS f32x4*)(x + (size_t)row * D + c) * sc, c1 = *(const GAS f32x4*)(x + (size_t)row * D + c + 4) * sc;
                const f32x4 o0 = (s0 * inv - c0) * gam0, o1 = (s1 * inv - c1) * gam1;
                *(GAS u32x4*)(PO + (size_t)row * D + c) = (u32x4){cvt_pk_bf16(o0.x, o0.y), cvt_pk_bf16(o0.z, o0.w), cvt_pk_bf16(o1.x, o1.y), cvt_pk_bf16(o1.z, o1.w)};
                const int ent = row + Wh, lev = row - Wh;
                if (ent < bhi) { const float se = rs[ent - (r0 - 8)]; s0 = s0 + *(const GAS f32x4*)(x + (size_t)ent * D + c) * se; s1 = s1 + *(const GAS f32x4*)(x + (size_t)ent * D + c + 4) * se; }
                if (lev >= blo) { const float sl = rs[lev - (r0 - 8)]; s0 = s0 - *(const GAS f32x4*)(x + (size_t)lev * D + c) * sl; s1 = s1 - *(const GAS f32x4*)(x + (size_t)lev * D + c + 4) * sl; } }
            __syncthreads();
        }
    }
    SEAM(0);

    if (IN(1)) {
        pg8::Gemm g{(const bf16*)(ws + WS_POOLED), (const bf16*)(ws + WS_POOLT), D, 512, 512};
        SchedPool S; S.T.init(M / 256, 8, G, bid);
        pg8::EpiPool E{x, Hh, p.in[3], (LAS float*)(lds + 131072), (float*)(ws + WS_PART)};
        pg8::gemm_phase<pg8::EpiPool, SchedPool, true, true>(lds, g, S, E);
    }
    SEAM(1);


    if (IN(3)) for (int rep_ = 0; rep_ < REP3; ++rep_) {
        pg8::Gemm g{(const bf16*)Hh, (const bf16*)(ws + WS_FFN1T), D, D, D};
        SchedPlain S; S.T.init(M / 256, 2 * FF0 / 256, G, bid); S.astep = (unsigned long long)256 * D * 2; S.bstep = (unsigned long long)256 * D * 2;
        if constexpr (FFN_DOWN_FP8) { pg8::EpiSwigluF8R E{ws + WS_ACT0, FF0, F8_SH0, (const float*)(ws + WS_PART)}; pg8::gemm_phase(lds, g, S, E); }
        else { pg8::EpiSwiglu E{(bf16*)(ws + WS_ACT0), FF0, (const float*)(ws + WS_PART)}; pg8::gemm_phase(lds, g, S, E); }
    }
    SEAM(3);

    if (IN(4)) {
        constexpr int KU = FFN_DOWN_FP8 ? FF0 / 2 : FF0;
        pg8::Gemm g{(const bf16*)(ws + WS_ACT0), (const bf16*)(ws + WS_FFN2T), KU, KU, KU};
        SchedPlain S; S.T.init(M / 256, D / 256, G, bid); S.astep = (unsigned long long)256 * KU * 2; S.bstep = (unsigned long long)256 * KU * 2;
        pg8::EpiResid E{Hh, FFN_DOWN_FP8 ? 1.0f / (F8_SH0 * F8_SWD0) : 1.0f};
        pg8::gemm_phase<pg8::EpiResid, SchedPlain, false, true, FFN_DOWN_FP8>(lds, g, S, E);
    }
    SEAM(4);

    if (IN(5)) for (int rep_ = 0; rep_ < REP5; ++rep_) {
        LAS float* rs = (LAS float*)lds;
        bf16* MX = (bf16*)(ws + WS_MIX);
        const int hf = tid >> 8, c = 8 * (tid & 255);
        const f32x4 gam0 = *(const GAS f32x4*)(p.in[8] + c), gam1 = *(const GAS f32x4*)(p.in[8] + c + 4);
        f32x4 mc0[6], mc1[6];
#pragma unroll
        for (int i = 0; i < 6; ++i) { mc0[i] = *(const GAS f32x4*)(p.in[9] + (size_t)i * D + c); mc1[i] = *(const GAS f32x4*)(p.in[9] + (size_t)i * D + c + 4); }
        for (int chunk = bid; chunk < NCHUNK; chunk += G) {
            const int r0 = chunk * 64, blo = (r0 / SEQ) * SEQ, bhi = blo + SEQ;
            {
#pragma unroll
                for (int i3 = 0; i3 < 3; ++i3) { u32x4 w[3][4]; bool ok[3];
#pragma unroll
                    for (int q3 = 0; q3 < 3; ++q3) { const int li = wave * 9 + 3 * i3 + q3; const int rr = r0 - 1 + li; ok[q3] = (li < 66 && rr >= blo && rr < bhi); const int rc = ok[q3] ? rr : r0;
#pragma unroll
                        for (int j = 0; j < 4; ++j) w[q3][j] = *(const GAS u32x4*)(Hh + (size_t)rc * D + 8 * lane + 512 * j); }
#pragma unroll
                    for (int q3 = 0; q3 < 3; ++q3) { float ss = 0.f;
#pragma unroll
                        for (int j = 0; j < 4; ++j) { f32x4 a4, c4; unpk8(w[q3][j], a4, c4); ss += ((a4.x * a4.x + a4.y * a4.y) + (a4.z * a4.z + a4.w * a4.w)) + ((c4.x * c4.x + c4.y * c4.y) + (c4.z * c4.z + c4.w * c4.w)); }
                        ss = wave_sum(ss); if (ok[q3] && lane == 0) rs[wave * 9 + 3 * i3 + q3] = rstd_of(ss); } } }
            __syncthreads();
            const f32x4 z4 = (f32x4){0.f, 0.f, 0.f, 0.f};
            const int rbeg = r0 + 32 * hf;
            auto ldrow = [&](int row, u32x4& w) { const int rc = (row >= blo && row < bhi) ? row : r0; w = *(const GAS u32x4*)(Hh + (size_t)rc * D + c); };
            auto cvrow = [&](int row, const u32x4& w, f32x4& o0, f32x4& o1) { if (row >= blo && row < bhi) { const float sc = rs[row - (r0 - 1)]; unpk8(w, o0, o1); o0 = o0 * sc * gam0; o1 = o1 * sc * gam1; } else { o0 = z4; o1 = z4; } };
            u32x4 wp, wc, wa, wb; ldrow(rbeg - 1, wp); ldrow(rbeg, wc); ldrow(rbeg + 1, wa);
            f32x4 p0, p1, c0, c1; cvrow(rbeg - 1, wp, p0, p1); cvrow(rbeg, wc, c0, c1);
            auto step = [&](int row, const u32x4& wnext) {
                f32x4 n0, n1; cvrow(row + 1, wnext, n0, n1);
                const f32x4 x0 = (p0 + n0) * 0.5f - c0, x1 = (p1 + n1) * 0.5f - c1;
#pragma unroll
                for (int i = 0; i < 6; ++i) { const f32x4 o0 = c0 + x0 * mc0[i], o1 = c1 + x1 * mc1[i];
                    __builtin_nontemporal_store(((u32x4){cvt_pk_bf16(o0.x, o0.y), cvt_pk_bf16(o0.z, o0.w), cvt_pk_bf16(o1.x, o1.y), cvt_pk_bf16(o1.z, o1.w)}), (GAS u32x4*)(MX + ((size_t)i * M + row) * D + c)); }
                p0 = c0; p1 = c1; c0 = n0; c1 = n1; };
            for (int t = 0; t < 32; t += 2) { const int row = rbeg + t;
                ldrow(row + 2, wb); step(row, wa);
                ldrow(row + 3, wa); step(row + 1, wb); }
            __syncthreads();
        }
    }
    SEAM(5);

    if (IN(6)) for (int rep_ = 0; rep_ < REP6; ++rep_) {
        pg8::Gemm g{(const bf16*)(ws + WS_MIX), (const bf16*)(ws + WS_RKVLOT), D, D, D};
        SchedRkvLo S; S.T.init(M / 256, 27, G, bid);
        pg8::EpiRkvLo E{(bf16*)(ws + WS_RKV), (bf16*)(ws + WS_LO)};
        pg8::gemm_phase(lds, g, S, E);
    }
    SEAM(6);

    if (IN(7)) for (int rep_ = 0; rep_ < REP7; ++rep_) {
        const bf16* LO_ = (const bf16*)(ws + WS_LO);
        for (int it = gw; it < 512 * 5 * 4; it += NGW) {
            const int cq = it & 3, tq = (it >> 2) % 5, rt = (it >> 2) / 5; const int m0 = rt * 32, n0 = cq * 512;
            if (tq < 2) lora_up_item<0>(LO_ + 96 * tq, 256, (const bf16*)(ws + WS_DW2T) + (size_t)tq * D * LOR, p.in[14] + (size_t)tq * D, (bf16*)(ws + WS_EW) + (size_t)tq * M * D, m0, n0, lane, lds + wave * 4608);
            else if (tq < 4) lora_up_item<1>(LO_ + (size_t)M * 256 + 96 * (tq - 2), 256, (const bf16*)(ws + WS_AW2T) + (size_t)(tq - 2) * D * LOR, p.in[17] + (size_t)(tq - 2) * D, (bf16*)(ws + WS_AA) + (size_t)(tq - 2) * M * D, m0, n0, lane, lds + wave * 4608);
            else lora_up_item_k256(LO_ + (size_t)2 * M * 256, (const bf16*)(ws + WS_G2T), (bf16*)(ws + WS_GG), m0, n0, lane, lds + wave * 4608);
        }
    }
    SEAM(7);

    if (IN(8)) for (int rep_ = 0; rep_ < REP8; ++rep_) {
        constexpr int PT = 144;
        constexpr int OFF_AT = 0, OFF_RT = 9216, OFF_BM = 18432, OFF_KM = 27648, OFF_BMT = 36864, OFF_KMT = 46080, OFF_VT = 55296;
        constexpr int OFF_LAB = 64512, OFF_LAK = 73728, OFF_MRB = 82944, OFF_MRK = 92160, OFF_TBB = 101376, OFF_LD = 103424, OFF_GC = 107520, OFF_WTOT = 107776, OFF_YB = 109824;
        const int q = lane >> 4, c16 = lane & 15;
        const bf16* RKV = (const bf16*)(ws + WS_RKV);
#define WK_NAT(off, row, kb) (*(const LAS bf16x8*)(lds + (off) + (row) * PT + ((kb) + 8 * q) * 2))
#define WK_MFMA(a, b, c) __builtin_amdgcn_mfma_f32_16x16x32_bf16((a), (b), (c), 0, 0, 0)
        auto ld_rho = [&](int off, int row, int kb) -> bf16x8 {
            const u32x2 lo2 = *(const LAS u32x2*)(lds + off + row * PT + (kb + 4 * q) * 2), hi2 = *(const LAS u32x2*)(lds + off + row * PT + (kb + 16 + 4 * q) * 2);
            const u32x4 w4 = (u32x4){lo2.x, lo2.y, hi2.x, hi2.y}; return __builtin_bit_cast(bf16x8, w4); };
        auto packB = [&](const f32x4& a, const f32x4& b) -> bf16x8 {
            const u32x4 w4 = (u32x4){cvt_pk_bf16(a[0], a[1]), cvt_pk_bf16(a[2], a[3]), cvt_pk_bf16(b[0], b[1]), cvt_pk_bf16(b[2], b[3])}; return __builtin_bit_cast(bf16x8, w4); };
        for (int i = tid; i < (OFF_LD - OFF_LAB) / 16; i += 512) *(LAS u32x4*)(lds + OFF_LAB + i * 16) = (u32x4){0u, 0u, 0u, 0u};
        __syncthreads();
        if (bid < 2 * BATCH * NH) { const int u = bid;
            const int dir = u / (BATCH * NH), b = (u % (BATCH * NH)) / NH, h = u % NH;
            const bool fwd = (dir == 0);
            const size_t rowbase = (size_t)b * SEQ; const int col = h * HS + lane;
            const bf16* EW = (const bf16*)(ws + WS_EW) + (size_t)dir * M * D; const bf16* AA = (const bf16*)(ws + WS_AA) + (size_t)dir * M * D;
            bf16* Yo = (bf16*)(ws + WS_Y) + (size_t)dir * M * D;
            const float kkc = p.in[22][col], kac = p.in[23][col], rkc = p.in[24][col];
            float* BSo = (float*)(ws + WS_BS) + (size_t)dir * M * NH;
            constexpr int OFF_PM = 126464;
            static_assert(OFF_PM + 64 * PT <= MISC_OFF, "Pm");
            f32x4 ST[4];
#pragma unroll
            for (int i = 0; i < 4; ++i) ST[i] = (f32x4){0.f, 0.f, 0.f, 0.f};
            constexpr int OFF_RAW = OFF_LAB;
            auto ldraw = [&](int cc, u32x4 (&pf)[5]) { cc = (cc < SEQ / 64) ? cc : SEQ / 64 - 1;
                const int tl = cc * 64 + 8 * wave + (lane >> 3); const int t = fwd ? tl : SEQ - 1 - tl; const size_t o = (rowbase + t) * D + h * HS + 8 * (lane & 7);
                pf[0] = __builtin_nontemporal_load((const GAS u32x4*)(RKV + o)); pf[1] = __builtin_nontemporal_load((const GAS u32x4*)(RKV + (size_t)M * D + o)); pf[2] = __builtin_nontemporal_load((const GAS u32x4*)(RKV + (size_t)2 * M * D + o));
                pf[3] = __builtin_nontemporal_load((const GAS u32x4*)(EW + o)); pf[4] = __builtin_nontemporal_load((const GAS u32x4*)(AA + o)); };
            u32x4 pfA[5], pfB[5];
            ldraw(0, pfA); ldraw(1, pfB);
            auto chunk_body = [&](const int c, u32x4 (&pf)[5]) __attribute__((always_inline)) {
                {
                    const int cp = (c > 0) ? c - 1 : 0;
#pragma unroll
                    for (int j = 0; j < 8; ++j) { const int tl = cp * 64 + 8 * wave + j; const int t = fwd ? tl : SEQ - 1 - tl;
                        Yo[(rowbase + t) * D + col] = (bf16)cvt_pk_bf16(((const LAS float*)(lds + OFF_YB))[(8 * wave + j) * 65 + lane], 0.f); } }
#pragma unroll
                for (int x5 = 0; x5 < 5; ++x5) *(LAS u32x4*)(lds + OFF_RAW + x5 * 8192 + (8 * wave + (lane >> 3)) * 128 + (lane & 7) * 16) = pf[x5];
                ldraw(c + 2, pf);
                f32x4 cvb[16]; const int cvit = (c * NCW + (wave - CVW0)) * 256 + bid;
                LDS_WAIT(); __builtin_amdgcn_s_barrier(); asm volatile("" ::: "memory");
                unsigned short rr_[8], rk_[8], rv_[8], re_[8], ra_[8];
#pragma unroll
                for (int j = 0; j < 8; ++j) { const LAS unsigned short* rp = (const LAS unsigned short*)(lds + OFF_RAW + (8 * wave + j) * 128 + lane * 2);
                    rr_[j] = rp[0]; rk_[j] = rp[4096]; rv_[j] = rp[8192]; re_[j] = rp[12288]; ra_[j] = rp[16384]; }
                float lgl[8]; { float cs = 0.f;
#pragma unroll
                    for (int j = 0; j < 8; ++j) { cs -= bf2f(re_[j]); lgl[j] = cs; } }
                ((LAS float*)(lds + OFF_WTOT))[wave * 64 + lane] = lgl[7];
                LDS_WAIT(); __builtin_amdgcn_s_barrier(); asm volatile("" ::: "memory");
                float off = 0.f;
                { float wt[8];
#pragma unroll
                  for (int w2 = 0; w2 < 8; ++w2) wt[w2] = ((const LAS float*)(lds + OFF_WTOT))[w2 * 64 + lane];
#pragma unroll
                  for (int w2 = 0; w2 < 7; ++w2) off += (w2 < wave) ? wt[w2] : 0.f; }
                {
                    unsigned bt[8], kt[8];
                    float rig_prev = __expf(off);
#pragma unroll
                    for (int j = 0; j < 8; ++j) { const int t = 8 * wave + j;
                        const float lg = off + lgl[j];
                        const float rf = bf2f(rr_[j]), kf = bf2f(rk_[j]), af = bf2f(ra_[j]);
                        const float kkr = kf * kkc; const float n2 = wave_sum(kkr * kkr); const float kkn = kkr * __builtin_amdgcn_rsqf(fmaxf(n2, 1e-24f));
                        const float ig = __expf(-lg), gt = __builtin_amdgcn_rcpf(ig), eg = rig_prev;
                        rig_prev = gt;
                        const unsigned ar_ = cvt_pk_bf16(-kkn * eg, rf * (fwd ? gt : eg));
                        const float kmod = kf * (1.0f + (af - 1.0f) * kac);
                        const unsigned bk_ = cvt_pk_bf16(kkn * af * ig, kmod * ig);
                        *(LAS unsigned short*)(lds + OFF_PM + t * PT + lane * 2) = (unsigned short)cvt_pk_bf16(rf * kmod * rkc, 0.f);
                        *(LAS unsigned short*)(lds + OFF_AT + t * PT + lane * 2) = (unsigned short)ar_;
                        *(LAS unsigned short*)(lds + OFF_RT + t * PT + lane * 2) = (unsigned short)(ar_ >> 16);
                        *(LAS unsigned short*)(lds + OFF_BM + t * PT + lane * 2) = (unsigned short)bk_;
                        *(LAS unsigned short*)(lds + OFF_KM + t * PT + lane * 2) = (unsigned short)(bk_ >> 16);
                        bt[j] = bk_ & 0xffffu; kt[j] = bk_ >> 16; }
                    *(LAS u32x4*)(lds + OFF_BMT + lane * PT + wave * 16) = (u32x4){bt[0] | (bt[1] << 16), bt[2] | (bt[3] << 16), bt[4] | (bt[5] << 16), bt[6] | (bt[7] << 16)};
                    *(LAS u32x4*)(lds + OFF_KMT + lane * PT + wave * 16) = (u32x4){kt[0] | (kt[1] << 16), kt[2] | (kt[3] << 16), kt[4] | (kt[5] << 16), kt[6] | (kt[7] << 16)};
                    *(LAS u32x4*)(lds + OFF_VT + lane * PT + wave * 16) = (u32x4){(unsigned)rv_[0] | ((unsigned)rv_[1] << 16), (unsigned)rv_[2] | ((unsigned)rv_[3] << 16), (unsigned)rv_[4] | ((unsigned)rv_[5] << 16), (unsigned)rv_[6] | ((unsigned)rv_[7] << 16)};
                    {
                        const int mtx = tid >> 7, tl2 = (tid >> 6) & 1, r16 = (tid >> 2) & 15;
                        const int offM = (mtx == 0) ? OFF_LAK : (mtx == 1) ? OFF_MRB : (mtx == 2) ? OFF_MRK : OFF_LAB;
                        *(LAS u32x2*)(lds + offM + (32 * tl2 + r16) * PT + (32 * tl2 + 16) * 2 + (tid & 3) * 8) = (u32x2){0u, 0u}; }
                    if (wave == 7) ((LAS float*)(lds + OFF_GC))[lane] = __expf(off + lgl[7]);
                }
                LDS_WAIT(); __builtin_amdgcn_s_barrier(); asm volatile("" ::: "memory");
                auto s1_tile = [&](int pr, int tt, int it) {
                    const int offX = (pr & 1) ? OFF_KM : OFF_BM, offY = (pr & 2) ? OFF_RT : OFF_AT;
                    const int offD = (pr == 0) ? OFF_LAB : (pr == 1) ? OFF_LAK : (pr == 2) ? OFF_MRB : OFF_MRK;
                    const bf16x8 x0 = WK_NAT(offX, 16 * it + c16, 0), x1 = WK_NAT(offX, 16 * it + c16, 32), y0 = WK_NAT(offY, 16 * tt + c16, 0), y1 = WK_NAT(offY, 16 * tt + c16, 32);
                    f32x4 acc = (f32x4){0.f, 0.f, 0.f, 0.f};
                    acc = WK_MFMA(x0, y0, acc); acc = WK_MFMA(x1, y1, acc);
                    const int t = 16 * tt + c16, i0 = 16 * it + 4 * q; const bool incl = (pr >= 2) && fwd;
#pragma unroll
                    for (int r4 = 0; r4 < 4; ++r4) { const int i = i0 + r4; const bool keep = incl ? (i <= t) : (i < t); acc[r4] = keep ? acc[r4] : 0.f; }
                    *(LAS u32x2*)(lds + offD + t * PT + i0 * 2) = (u32x2){cvt_pk_bf16(acc[0], acc[1]), cvt_pk_bf16(acc[2], acc[3])};
                    if (pr == 0 && tt == it) {
#pragma unroll
                        for (int r4 = 0; r4 < 4; ++r4) *(LAS float*)(lds + OFF_LD + tt * 1024 + (4 * q + r4) * 64 + c16 * 4) = acc[r4]; } };
                auto tile_of = [&](int ti, int& tt, int& it) { tt = (ti >= 6) ? 3 : (ti >= 3) ? 2 : (ti >= 1) ? 1 : 0; it = ti - (tt * (tt + 1)) / 2; };
                for (int n3 = 0; n3 < 3; ++n3) { const int a = wave * 3 + n3; int pr, tt, it;
                    if (a < 4) { pr = 0; tt = a; it = a; } else if (a < 14) { pr = 1; tile_of(a - 4, tt, it); } else { pr = 3; tile_of(a - 14, tt, it); }
                    s1_tile(pr, tt, it); }
                if (wave >= 4) {
                    const int blk = wave - 4; const bf16x8 ones = __builtin_bit_cast(bf16x8, ((u32x4){0x3F803F80u, 0x3F803F80u, 0x3F803F80u, 0x3F803F80u}));
                    f32x4 bsum = WK_MFMA(WK_NAT(OFF_PM, 16 * blk + c16, 0), ones, ((f32x4){0.f, 0.f, 0.f, 0.f})); bsum = WK_MFMA(WK_NAT(OFF_PM, 16 * blk + c16, 32), ones, bsum);
                    if (c16 == 0) {
#pragma unroll
                        for (int r4 = 0; r4 < 4; ++r4) { int ozb; asm volatile("v_mov_b32 %0, 0" : "=v"(ozb)); const int tlb = c * 64 + 16 * blk + 4 * (q + ozb) + r4; const int tb = fwd ? tlb : SEQ - 1 - tlb; BSo[(rowbase + tb) * NH + h] = bsum[r4]; } } }
                LDS_WAIT(); __builtin_amdgcn_s_barrier(); asm volatile("" ::: "memory");
                const f32x4 z4 = (f32x4){0.f, 0.f, 0.f, 0.f};
                bf16x8 Sb[2], Vb[2]; f32x4 accA[4], yv[4], sacc[4];
                if (wave == 4) {
                    if (CVW0 <= 4) moe_cv_load(p.in, cvit, cvb, lane);
                    {
                    float Tr[16];
                    const LAS float* Lq = (const LAS float*)(lds + OFF_LD + q * 1024);
                    int oz4; asm volatile("v_mov_b32 %0, 0" : "=v"(oz4));
#pragma unroll
                    for (int r = 0; r < 16; ++r) Tr[r] = (r == c16 + oz4) ? 1.0f : 0.0f;
#pragma unroll
                    for (int i = 0; i < 15; ++i) {
#pragma unroll
                        for (int k4 = (i + 1) / 4; k4 < 4; ++k4) { const f32x4 lv = *(const LAS f32x4*)(Lq + i * 16 + 4 * k4);
#pragma unroll
                            for (int e = 0; e < 4; ++e) if (4 * k4 + e > i) Tr[4 * k4 + e] += lv[e] * Tr[i]; } }
#pragma unroll
                    for (int r = 0; r < 16; ++r) *(LAS unsigned short*)(lds + OFF_TBB + q * 512 + r * 32 + c16 * 2) = (unsigned short)cvt_pk_bf16(Tr[r], 0.f);
                    }
                    LDS_WAIT(); __builtin_amdgcn_s_barrier(); asm volatile("" ::: "memory");
                    if (CVW0 <= 4) moe_cv_store(ws, cvit, cvb, lane);
                } else if (wave > 4) {
                    if (wave >= CVW0) moe_cv_load(p.in, cvit, cvb, lane);
                    f32x2 cvh[16]; const int hidx = (c * 3 + (wave - 5)) * 256 + bid; const bool hon = hidx < MOE_CV_HALVES;
                    if (hon) moe_cvh_load(p.in, MOE_CV_EARLY + (hidx >> 1), hidx & 1, cvh, lane);
                    for (int bb = wave - 5; bb < 16; bb += 3) { int pr, tt, it;
                        if (bb < 6) { pr = 0; const int ti = (bb == 0) ? 1 : (bb == 1) ? 3 : (bb == 2) ? 4 : (bb == 3) ? 6 : (bb == 4) ? 7 : 8; tile_of(ti, tt, it); } else { pr = 2; tile_of(bb - 6, tt, it); }
                        s1_tile(pr, tt, it); }
                    LDS_WAIT(); __builtin_amdgcn_s_barrier(); asm volatile("" ::: "memory");
                    if (wave >= CVW0) moe_cv_store(ws, cvit, cvb, lane);
                    if (hon) moe_cvh_store(ws, MOE_CV_EARLY + (hidx >> 1), hidx & 1, cvh, lane);
                } else {
                    Sb[0] = packB(ST[0], ST[1]); Sb[1] = packB(ST[2], ST[3]);
                    Vb[0] = WK_NAT(OFF_VT, 16 * wave + c16, 0); Vb[1] = WK_NAT(OFF_VT, 16 * wave + c16, 32);
                    {
                        bf16x8 fLak[6], fAt[8];
                        fLak[0] = WK_NAT(OFF_LAK, c16, 0); fLak[1] = WK_NAT(OFF_LAK, 16 + c16, 0); fLak[2] = WK_NAT(OFF_LAK, 32 + c16, 0); fLak[3] = WK_NAT(OFF_LAK, 32 + c16, 32); fLak[4] = WK_NAT(OFF_LAK, 48 + c16, 0); fLak[5] = WK_NAT(OFF_LAK, 48 + c16, 32);
#pragma unroll
                        for (int blk = 0; blk < 4; ++blk) { fAt[2 * blk] = ld_rho(OFF_AT, 16 * blk + c16, 0); fAt[2 * blk + 1] = ld_rho(OFF_AT, 16 * blk + c16, 32); }
                        __builtin_amdgcn_sched_barrier(0);
                        accA[0] = WK_MFMA(fLak[0], Vb[0], z4); accA[0] = WK_MFMA(fAt[0], Sb[0], accA[0]); accA[0] = WK_MFMA(fAt[1], Sb[1], accA[0]);
                        accA[1] = WK_MFMA(fLak[1], Vb[0], z4); accA[1] = WK_MFMA(fAt[2], Sb[0], accA[1]); accA[1] = WK_MFMA(fAt[3], Sb[1], accA[1]);
                        accA[2] = WK_MFMA(fLak[2], Vb[0], z4); accA[2] = WK_MFMA(fLak[3], Vb[1], accA[2]); accA[2] = WK_MFMA(fAt[4], Sb[0], accA[2]); accA[2] = WK_MFMA(fAt[5], Sb[1], accA[2]);
                        accA[3] = WK_MFMA(fLak[4], Vb[0], z4); accA[3] = WK_MFMA(fLak[5], Vb[1], accA[3]); accA[3] = WK_MFMA(fAt[6], Sb[0], accA[3]); accA[3] = WK_MFMA(fAt[7], Sb[1], accA[3]);
                    }
                    __builtin_amdgcn_sched_barrier(0);
                    {
                        bf16x8 fRt[8], fMrk[6];
#pragma unroll
                        for (int blk = 0; blk < 4; ++blk) { fRt[2 * blk] = ld_rho(OFF_RT, 16 * blk + c16, 0); fRt[2 * blk + 1] = ld_rho(OFF_RT, 16 * blk + c16, 32); }
                        fMrk[0] = WK_NAT(OFF_MRK, c16, 0); fMrk[1] = WK_NAT(OFF_MRK, 16 + c16, 0); fMrk[2] = WK_NAT(OFF_MRK, 32 + c16, 0); fMrk[3] = WK_NAT(OFF_MRK, 32 + c16, 32); fMrk[4] = WK_NAT(OFF_MRK, 48 + c16, 0); fMrk[5] = WK_NAT(OFF_MRK, 48 + c16, 32);
                        __builtin_amdgcn_sched_barrier(0);
                        yv[0] = WK_MFMA(fRt[0], Sb[0], z4); yv[0] = WK_MFMA(fRt[1], Sb[1], yv[0]); yv[0] = WK_MFMA(fMrk[0], Vb[0], yv[0]);
                        yv[1] = WK_MFMA(fRt[2], Sb[0], z4); yv[1] = WK_MFMA(fRt[3], Sb[1], yv[1]); yv[1] = WK_MFMA(fMrk[1], Vb[0], yv[1]);
                        yv[2] = WK_MFMA(fRt[4], Sb[0], z4); yv[2] = WK_MFMA(fRt[5], Sb[1], yv[2]); yv[2] = WK_MFMA(fMrk[2], Vb[0], yv[2]); yv[2] = WK_MFMA(fMrk[3], Vb[1], yv[2]);
                        yv[3] = WK_MFMA(fRt[6], Sb[0], z4); yv[3] = WK_MFMA(fRt[7], Sb[1], yv[3]); yv[3] = WK_MFMA(fMrk[4], Vb[0], yv[3]); yv[3] = WK_MFMA(fMrk[5], Vb[1], yv[3]);
                    }
                    __builtin_amdgcn_sched_barrier(0);
                    {
                        bf16x8 fK[8];
#pragma unroll
                        for (int kt = 0; kt < 4; ++kt) { fK[2 * kt] = WK_NAT(OFF_KMT, 16 * kt + c16, 0); fK[2 * kt + 1] = WK_NAT(OFF_KMT, 16 * kt + c16, 32); }
                        __builtin_amdgcn_sched_barrier(0);
#pragma unroll
                        for (int kt = 0; kt < 4; ++kt) { sacc[kt] = WK_MFMA(fK[2 * kt], Vb[0], ST[kt]); sacc[kt] = WK_MFMA(fK[2 * kt + 1], Vb[1], sacc[kt]); }
                    }
                    LDS_WAIT(); __builtin_amdgcn_s_barrier(); asm volatile("" ::: "memory");
                    bf16x8 fLab[4]; u32x2 fT[4];
                    fLab[0] = ld_rho(OFF_LAB, 16 + c16, 0); fLab[1] = ld_rho(OFF_LAB, 32 + c16, 0); fLab[2] = ld_rho(OFF_LAB, 48 + c16, 0); fLab[3] = ld_rho(OFF_LAB, 48 + c16, 32);
#pragma unroll
                    for (int blk = 0; blk < 4; ++blk) fT[blk] = *(const LAS u32x2*)(lds + OFF_TBB + blk * 512 + c16 * 32 + q * 8);
                    __builtin_amdgcn_sched_barrier(0);
                    f32x4 U[4]; bf16x8 Ub0, Ub1;
                    U[0] = WK_MFMA(__builtin_bit_cast(bf16x8, ((u32x4){fT[0].x, fT[0].y, 0u, 0u})), packB(accA[0], z4), z4);
                    accA[1] = WK_MFMA(fLab[0], packB(U[0], z4), accA[1]);
                    U[1] = WK_MFMA(__builtin_bit_cast(bf16x8, ((u32x4){fT[1].x, fT[1].y, 0u, 0u})), packB(accA[1], z4), z4);
                    Ub0 = packB(U[0], U[1]);
                    accA[2] = WK_MFMA(fLab[1], Ub0, accA[2]);
                    U[2] = WK_MFMA(__builtin_bit_cast(bf16x8, ((u32x4){fT[2].x, fT[2].y, 0u, 0u})), packB(accA[2], z4), z4);
                    accA[3] = WK_MFMA(fLab[2], Ub0, accA[3]); accA[3] = WK_MFMA(fLab[3], packB(U[2], z4), accA[3]);
                    U[3] = WK_MFMA(__builtin_bit_cast(bf16x8, ((u32x4){fT[3].x, fT[3].y, 0u, 0u})), packB(accA[3], z4), z4);
                    Ub1 = packB(U[2], U[3]);
                    __builtin_amdgcn_sched_barrier(0);
                    bf16x8 fMrb[6], fB[8]; f32x4 gc[4];
                    fMrb[0] = ld_rho(OFF_MRB, c16, 0); fMrb[1] = ld_rho(OFF_MRB, 16 + c16, 0); fMrb[2] = ld_rho(OFF_MRB, 32 + c16, 0); fMrb[3] = ld_rho(OFF_MRB, 32 + c16, 32); fMrb[4] = ld_rho(OFF_MRB, 48 + c16, 0); fMrb[5] = ld_rho(OFF_MRB, 48 + c16, 32);
#pragma unroll
                    for (int kt = 0; kt < 4; ++kt) { fB[2 * kt] = ld_rho(OFF_BMT, 16 * kt + c16, 0); fB[2 * kt + 1] = ld_rho(OFF_BMT, 16 * kt + c16, 32); gc[kt] = *(const LAS f32x4*)(lds + OFF_GC + (16 * kt + 4 * q) * 4); }
                    __builtin_amdgcn_sched_barrier(0);
                    yv[0] = WK_MFMA(fMrb[0], Ub0, yv[0]); yv[1] = WK_MFMA(fMrb[1], Ub0, yv[1]);
                    yv[2] = WK_MFMA(fMrb[2], Ub0, yv[2]); yv[2] = WK_MFMA(fMrb[3], Ub1, yv[2]);
                    yv[3] = WK_MFMA(fMrb[4], Ub0, yv[3]); yv[3] = WK_MFMA(fMrb[5], Ub1, yv[3]);
#pragma unroll
                    for (int kt = 0; kt < 4; ++kt) { f32x4 a = WK_MFMA(fB[2 * kt], Ub0, sacc[kt]); a = WK_MFMA(fB[2 * kt + 1], Ub1, a); ST[kt] = a * gc[kt]; }
#pragma unroll
                    for (int blk = 0; blk < 4; ++blk)
#pragma unroll
                        for (int i = 0; i < 4; ++i) ((LAS float*)(lds + OFF_YB))[(16 * blk + 4 * q + i) * 65 + 16 * wave + c16] = yv[blk][i];
                }
                LDS_WAIT(); __builtin_amdgcn_s_barrier(); asm volatile("" ::: "memory");
            };
            for (int c2 = 0; c2 < SEQ / 64; c2 += 2) { chunk_body(c2, pfA); chunk_body(c2 + 1, pfB); }
            {
#pragma unroll
                for (int j = 0; j < 8; ++j) { const int tl = (SEQ / 64 - 1) * 64 + 8 * wave + j; const int t = fwd ? tl : SEQ - 1 - tl;
                    Yo[(rowbase + t) * D + col] = (bf16)cvt_pk_bf16(((const LAS float*)(lds + OFF_YB))[(8 * wave + j) * 65 + lane], 0.f); }
            }
            __syncthreads();
        }
#undef WK_NAT
#undef WK_MFMA
        __syncthreads();
    }
    SEAM(8);

    if (IN(9)) for (int rep_ = 0; rep_ < REP9; ++rep_) {
        const bf16* YF = (const bf16*)(ws + WS_Y); const bf16* YB = YF + (size_t)M * D;
        const bf16* RKV = (const bf16*)(ws + WS_RKV); const float* BS = (const float*)(ws + WS_BS); const bf16* GG = (const bf16*)(ws + WS_GG);
        bf16* PO = (bf16*)(ws + WS_PO);
        auto unpk = [](const u32x4& w, float (&f)[8]) {
#pragma unroll
            for (int i = 0; i < 4; ++i) { f[2 * i] = __uint_as_float(w[i] << 16); f[2 * i + 1] = __uint_as_float(w[i] & 0xffff0000u); } };
        auto row8_sum = [](float v) { v += dppmov<0xB1>(v); v += dppmov<0x4E>(v); v += dppmov<0x141>(v); return v; };
        for (int j = 0; j < 4; ++j) { const int cc = 8 * lane + 512 * j;
            float lw[8], lb[8];
#pragma unroll
            for (int i = 0; i < 8; ++i) { lw[i] = p.in[25][cc + i]; lb[i] = p.in[26][cc + i]; }
            for (int m = gw; m < M; m += NGW) { const size_t o = (size_t)m * D + cc;
                const u32x4 yfw = __builtin_nontemporal_load((const GAS u32x4*)(YF + o)), ybw = __builtin_nontemporal_load((const GAS u32x4*)(YB + o)), vw = __builtin_nontemporal_load((const GAS u32x4*)(RKV + (size_t)2 * M * D + o));
                const u32x4 gw4 = __builtin_nontemporal_load((const GAS u32x4*)(GG + o));
                const float bs = BS[(size_t)m * NH + (lane >> 3) + 8 * j];
                float yf[8], yb[8], vf[8], gf[8], y[8];
                unpk(yfw, yf); unpk(ybw, yb); unpk(vw, vf); unpk(gw4, gf);
                float s = 0.f;
#pragma unroll
                for (int i = 0; i < 8; ++i) { y[i] = yf[i] + yb[i]; s += y[i]; }
                const float mu = row8_sum(s) * (1.0f / 64.0f);
                float qv = 0.f;
#pragma unroll
                for (int i = 0; i < 8; ++i) { y[i] -= mu; qv += y[i] * y[i]; }
                const float rstd = 1.0f / sqrtf(row8_sum(qv) * (1.0f / 64.0f) + LNX_EPS);
                float ov[8];
#pragma unroll
                for (int i = 0; i < 8; ++i) ov[i] = (y[i] * rstd * lw[i] + lb[i] + vf[i] * bs) * gf[i];
                *(GAS u32x4*)(PO + o) = (u32x4){cvt_pk_bf16(ov[0], ov[1]), cvt_pk_bf16(ov[2], ov[3]), cvt_pk_bf16(ov[4], ov[5]), cvt_pk_bf16(ov[6], ov[7])}; }
        }
    }
    SEAM(9);

    if (IN(10)) {
        pg8::Gemm g{(const bf16*)(ws + WS_PO), (const bf16*)(ws + WS_WOT), D, D, D};
        SchedPlain S; S.T.init(M / 256, D / 256, G, bid); S.astep = (unsigned long long)256 * D * 2; S.bstep = (unsigned long long)256 * D * 2;
        pg8::EpiResid E{Hh};
        pg8::gemm_phase<pg8::EpiResid, SchedPlain, false, true>(lds, g, S, E);
    }
    SEAM(10);

    if (IN(11)) for (int rep_ = 0; rep_ < REP11; ++rep_) {
        {
            constexpr int NT_ = MOE_NT;
            auto ld_it = [&](int it, f32x4 (&v)[16]) { moe_cv_load(p.in, it, v, lane); };
            auto st_it = [&](int it, const f32x4 (&v)[16]) { moe_cv_store(ws, it, v, lane); };
            f32x4 va[16], vb[16];
            int it = MOE_CV_EARLY + MOE_CV_HALVES / 2 + gw; if (it < NT_) ld_it(it, va);
            while (it < NT_) {
                int n1 = it + NGW; if (n1 < NT_) ld_it(n1, vb);
                st_it(it, va); it = n1; if (it >= NT_) break;
                int n2 = it + NGW; if (n2 < NT_) ld_it(n2, va);
                st_it(it, vb); it = n2; }
        }
        __syncthreads();
        LAS float* rt = (LAS float*)lds;
        LAS int* lcnt = (LAS int*)(lds + 65536);
        for (int i = tid; i < D * NE; i += 512) { const int c = i >> 3, e = i & 7; const int l = (c & 511) >> 3, j = c >> 9, hf = (c >> 2) & 1, ii = c & 3; rt[((e * 4 + j) * 2 + hf) * 256 + l * 4 + ii] = p.in[28][i]; }
        unsigned char* HN2 = ws + WS_HN2; i32x4* SEL = (i32x4*)(ws + WS_SEL); int* CNT = (int*)(ws + WS_CNT);
        for (int chunk = bid; chunk < NCHUNK; chunk += G) {
            if (tid < 8) lcnt[tid] = 0;
            __syncthreads();
            f32x4 gm[8];
#pragma unroll
            for (int j = 0; j < 4; ++j) { gm[2 * j] = *(const GAS f32x4*)(p.in[27] + 8 * lane + 512 * j); gm[2 * j + 1] = *(const GAS f32x4*)(p.in[27] + 8 * lane + 512 * j + 4); }
            auto ldrow = [&](int i, u32x4 (&w)[4]) { const int m = chunk * 64 + wave * 8 + ((i < 8) ? i : 7);
#pragma unroll
                for (int j = 0; j < 4; ++j) w[j] = __builtin_nontemporal_load((const GAS u32x4*)(Hh + (size_t)m * D + 8 * lane + 512 * j)); };
            auto dotok = [&](int i, const u32x4 (&w)[4]) { const int m = chunk * 64 + wave * 8 + i;
                f32x4 v[8]; float s = 0.f;
#pragma unroll
                for (int j = 0; j < 4; ++j) unpk8(w[j], v[2 * j], v[2 * j + 1]);
#pragma unroll
                for (int j = 0; j < 8; ++j) s += (v[j].x * v[j].x + v[j].y * v[j].y) + (v[j].z * v[j].z + v[j].w * v[j].w);
                const float rsd = rstd_of(wave_sum(s));
                float lg[8];
#pragma unroll
                for (int e = 0; e < 8; ++e) lg[e] = 0.f;
#pragma unroll
                for (int j = 0; j < 4; ++j) {
                    const f32x4 h0 = v[2 * j] * rsd * gm[2 * j], h1 = v[2 * j + 1] * rsd * gm[2 * j + 1];
                    *(GAS u32x2*)(HN2 + (size_t)m * D + 8 * lane + 512 * j) = (u32x2){pk4_fp8(h0.x * F8_SA, h0.y * F8_SA, h0.z * F8_SA, h0.w * F8_SA), pk4_fp8(h1.x * F8_SA, h1.y * F8_SA, h1.z * F8_SA, h1.w * F8_SA)};
#pragma unroll
                    for (int e = 0; e < 8; ++e) { const f32x4 r0 = *(const LAS f32x4*)(rt + ((e * 4 + j) * 2) * 256 + lane * 4), r1 = *(const LAS f32x4*)(rt + ((e * 4 + j) * 2 + 1) * 256 + lane * 4);
                        lg[e] += ((h0.x * r0.x + h0.y * r0.y) + (h0.z * r0.z + h0.w * r0.w)) + ((h1.x * r1.x + h1.y * r1.y) + (h1.z * r1.z + h1.w * r1.w)); } }
#pragma unroll
                for (int e = 0; e < 8; ++e) lg[e] = wave_sum(lg[e]);
                int e1 = 0; float v1 = lg[0];
#pragma unroll
                for (int e = 1; e < 8; ++e) if (lg[e] > v1) { v1 = lg[e]; e1 = e; }
                int e2 = -1; float v2 = -3.0e38f;
#pragma unroll
                for (int e = 0; e < 8; ++e) if (e != e1 && lg[e] > v2) { v2 = lg[e]; e2 = e; }
                const float g1 = 1.0f / (1.0f + expf(v2 - v1)), g2 = 1.0f - g1;
                if (lane == 0) { SEL[m] = (i32x4){e1 | (e2 << 8), __float_as_int(g1), __float_as_int(g2), 0}; atomicAdd((int*)&lcnt[e1], 1); atomicAdd((int*)&lcnt[e2], 1); } };
            u32x4 wa[4], wb[4]; ldrow(0, wa);
            for (int i = 0; i < 8; i += 2) { ldrow(i + 1, wb); dotok(i, wa); ldrow(i + 2, wa); dotok(i + 1, wb); }
            __syncthreads();
            if (tid < 8) CNT[chunk * 8 + tid] = lcnt[tid];
            __syncthreads();
        }
    }
    SEAM(11);

    if (IN(12)) for (int rep_ = 0; rep_ < REP12; ++rep_) {
        LAS int* pre = (LAS int*)lds;
        LAS int* tot = pre + NCHUNK * 8;
        LAS int* posb = tot + 32;
        const int* CNT = (const int*)(ws + WS_CNT); const i32x4* SEL = (const i32x4*)(ws + WS_SEL);
        i32x2* META = (i32x2*)(ws + WS_META); unsigned* TILEE = (unsigned*)(ws + WS_TILEE);
        const unsigned char* HN2 = ws + WS_HN2; unsigned char* AG = ws + WS_AG;
        for (int i = tid; i < NCHUNK * 8; i += 512) pre[i] = CNT[i];
        __syncthreads();
        {
            const int e = wave; int v4[4]; int t4 = 0;
#pragma unroll
            for (int k = 0; k < 4; ++k) { v4[k] = pre[(4 * lane + k) * 8 + e]; t4 += v4[k]; }
            int incl = t4;
#pragma unroll
            for (int o = 1; o < 64; o <<= 1) { const int u = __shfl_up(incl, o); if (lane >= o) incl += u; }
            int run = incl - t4;
#pragma unroll
            for (int k = 0; k < 4; ++k) { pre[(4 * lane + k) * 8 + e] = run; run += v4[k]; }
            if (lane == 63) tot[e] = incl; }
        __syncthreads();
        if (tid == 0) { int base = 0; for (int e = 0; e < 8; ++e) { const int nt_ = (tot[e] + 255) >> 8; tot[8 + e] = base; tot[16 + e] = nt_; base += nt_ * 256; } tot[24] = base >> 8; }
        __syncthreads();
        if (bid == 0) {
            if (tid == 0) { int ti = 0; for (int e = 0; e < 8; ++e) for (int k = 0; k < tot[16 + e]; ++k) TILEE[ti++] = (unsigned)e; TILEE[200] = (unsigned)tot[24]; }
        }
        for (int e = bid; e < 8; e += G) { const int pbeg = tot[8 + e] + tot[e], pend = tot[8 + e] + tot[16 + e] * 256;
            for (int r = pbeg + wave; r < pend; r += 8) { if (lane == 0) META[r] = (i32x2){-1, 0};
#pragma unroll
                for (int j = 0; j < 2; ++j) *((GAS u32x4*)(AG + (size_t)r * D) + lane + 64 * j) = (u32x4){0u, 0u, 0u, 0u}; } }
        for (int chunk = bid; chunk < NCHUNK; chunk += G) {
            if (wave == 0) { const int m = chunk * 64 + lane; const i32x4 s = SEL[m]; const int e1 = s.x & 0xff, e2 = (s.x >> 8) & 0xff;
                int p1 = 0, p2 = 0;
#pragma unroll
                for (int e = 0; e < 8; ++e) { const unsigned long long mk = __ballot((e1 == e) || (e2 == e)); const int rank = __popcll(mk & ((1ull << lane) - 1ull)); const int pos = tot[8 + e] + pre[chunk * 8 + e] + rank; if (e1 == e) p1 = pos; if (e2 == e) p2 = pos; }
                posb[2 * lane] = p1; posb[2 * lane + 1] = p2; ((i32x2*)(ws + WS_POS))[m] = (i32x2){p1, p2};
                META[p1] = (i32x2){m, s.y}; META[p2] = (i32x2){m | (1 << 14), s.z}; }
            __syncthreads();
            {   u32x4 rv[8][2];
#pragma unroll
                for (int q = 0; q < 8; ++q) { const int m = chunk * 64 + wave * 8 + q; const GAS u32x4* src = (const GAS u32x4*)(HN2 + (size_t)m * D) + lane;
#pragma unroll
                    for (int j = 0; j < 2; ++j) rv[q][j] = __builtin_nontemporal_load(src + 64 * j); }
#pragma unroll
                for (int q = 0; q < 8; ++q)
#pragma unroll
                    for (int sl = 0; sl < 2; ++sl) { const int pos = posb[(wave * 8 + q) * 2 + sl]; GAS u32x4* dst = (GAS u32x4*)(AG + (size_t)pos * D) + lane;
#pragma unroll
                        for (int j = 0; j < 2; ++j) dst[64 * j] = rv[q][j]; } }
            __syncthreads();
        }
    }
    SEAM(12);

    if (IN(13)) for (int rep_ = 0; rep_ < REP13; ++rep_) {
        const unsigned* TILEE = (const unsigned*)(ws + WS_TILEE);
        const int ntiles = (int)__builtin_amdgcn_readfirstlane(__hip_atomic_load(TILEE + 200, __ATOMIC_RELAXED, __HIP_MEMORY_SCOPE_AGENT));
        LAS unsigned* tl = (LAS unsigned*)(lds + 131072);
        if (tid < MAXTILES) tl[tid] = __hip_atomic_load(TILEE + tid, __ATOMIC_RELAXED, __HIP_MEMORY_SCOPE_AGENT);
        __syncthreads();
        pg8::Gemm g{(const bf16*)(ws + WS_AG), (const bf16*)(ws + WS_WGUT), D / 2, D / 2, D / 2};
        SchedMoe S; S.T.init(ntiles, 2 * FFE / 256, G, bid); S.tile_e = tl; S.astep = (unsigned long long)256 * D; S.bstep = (unsigned long long)256 * D; S.nN = 2 * FFE / 256;
        pg8::EpiSwigluF8 E{ws + WS_ACT1, FFE, 1.0f / (F8_SA * F8_SWU)};
        pg8::gemm_phase<pg8::EpiSwigluF8, SchedMoe, true, true, true>(lds, g, S, E);
    }
    SEAM(13);

    if (IN(14)) for (int rep_ = 0; rep_ < REP14; ++rep_) {
        const unsigned* TILEE = (const unsigned*)(ws + WS_TILEE);
        const int ntiles = (int)__builtin_amdgcn_readfirstlane(__hip_atomic_load(TILEE + 200, __ATOMIC_RELAXED, __HIP_MEMORY_SCOPE_AGENT));
        LAS unsigned* tl = (LAS unsigned*)(lds + 131072);
        if (tid < MAXTILES) tl[tid] = __hip_atomic_load(TILEE + tid, __ATOMIC_RELAXED, __HIP_MEMORY_SCOPE_AGENT);
        __syncthreads();
        pg8::EpiMoeDown E{(const i32x2*)(ws + WS_META), (bf16*)(ws + WS_YM), (bf16*)(ws + WS_P2), 1.0f / (F8_SH * F8_SWD)};
        {
            pg8::Gemm g{(const bf16*)(ws + WS_ACT1), (const bf16*)(ws + WS_WDT), FFE / 2, FFE / 2, FFE / 2};
            SchedMoe S; S.T.init(128, D / 256, G, bid); S.tile_e = tl; S.astep = (unsigned long long)256 * FFE; S.bstep = (unsigned long long)256 * FFE; S.nN = D / 256;
            pg8::gemm_phase<pg8::EpiMoeDown, SchedMoe, true, true, true>(lds, g, S, E);
        }
        {
            pg8::Gemm g{(const bf16*)(ws + WS_ACT1), (const bf16*)(ws + WS_WDT), FFE / 2, FFE / 2, KQ / 2};
            SchedMoeTail S; S.nq = (ntiles - 128) * 32; S.G = G; S.c = bid; S.tile_e = tl;
            pg8::gemm_phase<pg8::EpiMoeDown, SchedMoeTail, true, true, true>(lds, g, S, E);
        }
    }
    SEAM(14);

    if (IN(15)) for (int rep_ = 0; rep_ < REP15; ++rep_) {
        const bf16* Y0 = (const bf16*)(ws + WS_YM); const bf16* Y1 = Y0 + (size_t)M * D; const bf16* P2b = (const bf16*)(ws + WS_P2);
        auto addbf = [](f32x4& a, f32x4& c, const u32x4 w) {
            a = a + (f32x4){__uint_as_float(w.x << 16), __uint_as_float(w.x & 0xffff0000u), __uint_as_float(w.y << 16), __uint_as_float(w.y & 0xffff0000u)};
            c = c + (f32x4){__uint_as_float(w.z << 16), __uint_as_float(w.z & 0xffff0000u), __uint_as_float(w.w << 16), __uint_as_float(w.w & 0xffff0000u)}; };
        for (int m = gw; m < M; m += NGW) {
            const i32x2 ps = ((const i32x2*)(ws + WS_POS))[m];
            const int pq0 = __builtin_amdgcn_readfirstlane(ps.x), pq1 = __builtin_amdgcn_readfirstlane(ps.y);
            f32x4 v[8]; float s = 0.f;
#pragma unroll
            for (int j = 0; j < 4; ++j) { const size_t o = (size_t)m * D + 8 * lane + 512 * j;
                unpk8(__builtin_nontemporal_load((const GAS u32x4*)(Hh + o)), v[2 * j], v[2 * j + 1]);
                addbf(v[2 * j], v[2 * j + 1], __builtin_nontemporal_load((const GAS u32x4*)(Y0 + o))); addbf(v[2 * j], v[2 * j + 1], __builtin_nontemporal_load((const GAS u32x4*)(Y1 + o))); }
            for (int sl = 0; sl < 2; ++sl) { const int pq = sl ? pq1 : pq0;
                if (pq >= SPLIT_ROW0) {
                    for (int qq = 0; qq < 3; ++qq) { const bf16* pr = P2b + ((size_t)qq * 2048 + (pq - SPLIT_ROW0)) * D + 8 * lane;
#pragma unroll
                        for (int j = 0; j < 4; ++j) addbf(v[2 * j], v[2 * j + 1], *(const GAS u32x4*)(pr + 512 * j)); } } }
#pragma unroll
            for (int j = 0; j < 8; ++j) s += (v[j].x * v[j].x + v[j].y * v[j].y) + (v[j].z * v[j].z + v[j].w * v[j].w);
            const float rsd = rstd_of(wave_sum(s));
#pragma unroll
            for (int j = 0; j < 4; ++j) { const size_t o = (size_t)m * D + 8 * lane + 512 * j; const f32x4 g0 = *(const GAS f32x4*)(p.in[32] + 8 * lane + 512 * j), g1 = *(const GAS f32x4*)(p.in[32] + 8 * lane + 512 * j + 4);
                __builtin_nontemporal_store(v[2 * j] * rsd * g0, (GAS f32x4*)(p.out + o)); __builtin_nontemporal_store(v[2 * j + 1] * rsd * g1, (GAS f32x4*)(p.out + o + 4)); }
        }
    }
#undef IN
#undef SEAM
}

#ifndef MK_N_LAUNCHES
#define MK_N_LAUNCHES 1
#endif
constexpr int N_PHASES = 16;
extern "C" void kernel_launch(void* const* d_in, const int* in_sizes, int n_in, void* d_out, int out_size, void* d_ws, size_t ws_size, hipStream_t stream) {
    static int grid = 0;
    if (grid == 0) {
        if (n_in != 33 || out_size != M * D || ws_size < WS_END) { fprintf(stderr, "kernel_launch: unexpected shapes: n_in %d out %d ws %zu (need %zu)\n", n_in, out_size, ws_size, (size_t)WS_END); grid = -1; return; }
        int dev = 0, cus = 0, per_cu = 0;
        if (hipGetDevice(&dev) != hipSuccess || hipDeviceGetAttribute(&cus, hipDeviceAttributeMultiprocessorCount, dev) != hipSuccess) { grid = -1; return; }
        if (hipFuncSetAttribute((const void*)fwd_kernel, hipFuncAttributeMaxDynamicSharedMemorySize, LDS_BYTES) != hipSuccess) { fprintf(stderr, "kernel_launch: hipFuncSetAttribute failed\n"); grid = -1; return; }
        if (hipOccupancyMaxActiveBlocksPerMultiprocessor(&per_cu, (const void*)fwd_kernel, 512, LDS_BYTES) != hipSuccess || per_cu < 1) { fprintf(stderr, "kernel_launch: occupancy query says %d\n", per_cu); (void)hipGetLastError(); }
        grid = cus;
        if (grid < 2 * BATCH * NH) { fprintf(stderr, "kernel_launch: needs >= 256 CUs (one WKV scan per workgroup), got %d\n", grid); grid = -1; return; }
    }
    if (grid < 0) return;
    (void)hipMemsetAsync((char*)d_ws + WS_CTL, 0, CTL_ZERO_BYTES, stream);
    Params p{};
    for (int i = 0; i < 33; ++i) p.in[i] = (const float*)d_in[i];
    p.out = (float*)d_out; p.ws = (unsigned char*)d_ws;
#if MK_N_LAUNCHES == 1
    p.ph_lo = 0; p.ph_hi = N_PHASES;
    hipLaunchKernelGGL(fwd_kernel, dim3(grid), dim3(512), LDS_BYTES, stream, p);
#else
    for (int k = 0; k < N_PHASES; ++k) { p.ph_lo = k; p.ph_hi = k + 1; hipLaunchKernelGGL(fwd_kernel, dim3(grid), dim3(512), LDS_BYTES, stream, p); }
#endif
}
```
